# Optimizing an MI355X kernel written in HIP

```python
import jax, jax.numpy as jnp
from jax import lax
import numpy as np

D_MODEL = 2048
BATCH = 1
SEQ = 8192
DEPTH = 1
DEC_BATCH = 32
DEC_SEQ = 16
PAST_LEN = 4096

CHUNK = 64
N_META = 16
CONV_CH = D_MODEL // 2
POOL_CH = D_MODEL - CONV_CH
MIX_WIDTH = CONV_CH + POOL_CH
CONV_K = 31
POOL_WINDOWS = (2, 4, 8, 16)
N_POOL_GROUPS = len(POOL_WINDOWS)
POOL_GROUP = POOL_CH // N_POOL_GROUPS
POOL_HIST = max(POOL_WINDOWS) - 1
D_FF = ((8 * D_MODEL // 3 + 255) // 256) * 256
EPS = 1e-6

kernel_name = 'hybrid_conv_pool_streaming_encoder_step'


def rmsnorm(x, g):
    xf = x.astype(jnp.float32)
    y = xf * lax.rsqrt(jnp.mean(xf * xf, axis=-1, keepdims=True) + EPS)
    return (y * g.astype(jnp.float32)).astype(x.dtype)


def swiglu(x, w_gate, w_up, w_down):
    return (jax.nn.silu(x @ w_gate) * (x @ w_up)) @ w_down


def causal_dwconv(u_ext, w, b):
    c = u_ext.shape[-1]
    y = lax.conv_general_dilated(
        u_ext, w[:, None, :].astype(u_ext.dtype), window_strides=(1,), padding='VALID',
        dimension_numbers=('NWC', 'WIO', 'NWC'), feature_group_count=c)
    return y + b.astype(y.dtype)


def multiscale_pool(u_ext, n_hist):
    total = u_ext.shape[1]
    uf = u_ext.astype(jnp.float32)
    cs = jnp.concatenate([jnp.zeros_like(uf[:, :1]), jnp.cumsum(uf, axis=1)], axis=1)
    idx = np.arange(n_hist, total)
    cs_end = cs[:, n_hist + 1:]
    outs = []
    for g, w in enumerate(POOL_WINDOWS):
        lo = np.maximum(idx + 1 - w, 0)
        count = jnp.asarray((idx + 1 - lo).astype(np.float32))[None, :, None]
        sl = slice(g * POOL_GROUP, (g + 1) * POOL_GROUP)
        window_sum = cs_end[:, :, sl] - jnp.take(cs[:, :, sl], jnp.asarray(lo), axis=1)
        outs.append(window_sum / count - uf[:, n_hist:, sl])
    return jnp.stack(outs, axis=2).astype(u_ext.dtype)


def encoder_layer(x, conv_hist, pool_hist,
                  ffn1_norm, ffn1_w_gate, ffn1_w_up, ffn1_w_down,
                  mix_norm, w_in, conv_w, conv_b, conv_norm, pool_w, pool_scale, w_out,
                  ffn2_norm, ffn2_w_gate, ffn2_w_up, ffn2_w_down):
    b, l, _ = x.shape
    h = x + 0.5 * swiglu(rmsnorm(x, ffn1_norm), ffn1_w_gate, ffn1_w_up, ffn1_w_down)
    z = rmsnorm(h, mix_norm) @ w_in
    a = z[..., :CONV_CH]
    gate = z[..., CONV_CH:2 * CONV_CH]
    u_pool = z[..., 2 * CONV_CH:]
    u_conv = a * jax.nn.sigmoid(gate)
    conv_ext = jnp.concatenate([conv_hist.astype(u_conv.dtype), u_conv], axis=1)
    c = jax.nn.silu(rmsnorm(causal_dwconv(conv_ext, conv_w, conv_b), conv_norm))
    pool_ext = jnp.concatenate([pool_hist.astype(u_pool.dtype), u_pool], axis=1)
    p = multiscale_pool(pool_ext, pool_hist.shape[1])
    p = jnp.einsum('blgc,gcd->blgd', p, pool_w).reshape(b, l, POOL_CH) * pool_scale
    h = h + jnp.concatenate([c, p], axis=-1) @ w_out
    h = h + 0.5 * swiglu(rmsnorm(h, ffn2_norm), ffn2_w_gate, ffn2_w_up, ffn2_w_down)
    return h, conv_ext[:, -(CONV_K - 1):], pool_ext[:, -POOL_HIST:]


def setup_inputs(seed: int = 0) -> dict:
    key = jax.random.key(seed)
    ks = jax.random.split(key, 24)

    def nrm(k, shape, fan_in):
        return jax.random.normal(k, shape, jnp.float32) * (fan_in ** -0.5)

    def gain(k, shape):
        return 1.0 + 0.05 * jax.random.normal(k, shape, jnp.float32)

    return {
        'x_prompt': jax.random.normal(ks[0], (BATCH, SEQ, D_MODEL), jnp.float32),
        'x_sample': jax.random.normal(ks[1], (DEC_BATCH, DEC_SEQ, D_MODEL), jnp.float32),
        'state_conv': 0.5 * jax.random.normal(ks[2], (DEPTH, DEC_BATCH, CONV_K - 1, CONV_CH), jnp.float32),
        'state_pool': jax.random.normal(ks[3], (DEPTH, DEC_BATCH, POOL_HIST, POOL_CH), jnp.float32),
        'meta_tokens': jax.random.normal(ks[4], (N_META, D_MODEL), jnp.float32),
        'ffn1_norm': gain(ks[5], (DEPTH, D_MODEL)),
        'ffn1_w_gate': nrm(ks[6], (DEPTH, D_MODEL, D_FF), D_MODEL),
        'ffn1_w_up': nrm(ks[7], (DEPTH, D_MODEL, D_FF), D_MODEL),
        'ffn1_w_down': nrm(ks[8], (DEPTH, D_FF, D_MODEL), D_FF),
        'mix_norm': gain(ks[9], (DEPTH, D_MODEL)),
        'w_in': nrm(ks[10], (DEPTH, D_MODEL, 2 * CONV_CH + POOL_CH), D_MODEL),
        'conv_w': nrm(ks[11], (DEPTH, CONV_K, CONV_CH), CONV_K),
        'conv_b': 0.02 * jax.random.normal(ks[12], (DEPTH, CONV_CH), jnp.float32),
        'conv_norm': gain(ks[13], (DEPTH, CONV_CH)),
        'pool_w': nrm(ks[14], (DEPTH, N_POOL_GROUPS, POOL_GROUP, POOL_GROUP), POOL_GROUP),
        'pool_scale': gain(ks[15], (DEPTH, POOL_CH)),
        'w_out': nrm(ks[16], (DEPTH, MIX_WIDTH, D_MODEL), MIX_WIDTH),
        'ffn2_norm': gain(ks[17], (DEPTH, D_MODEL)),
        'ffn2_w_gate': nrm(ks[18], (DEPTH, D_MODEL, D_FF), D_MODEL),
        'ffn2_w_up': nrm(ks[19], (DEPTH, D_MODEL, D_FF), D_MODEL),
        'ffn2_w_down': nrm(ks[20], (DEPTH, D_FF, D_MODEL), D_FF),
        'final_norm': gain(ks[21], (D_MODEL,)),
    }


def reference(x_prompt, x_sample, state_conv, state_pool, meta_tokens,
              ffn1_norm, ffn1_w_gate, ffn1_w_up, ffn1_w_down,
              mix_norm, w_in, conv_w, conv_b, conv_norm, pool_w, pool_scale, w_out,
              ffn2_norm, ffn2_w_gate, ffn2_w_up, ffn2_w_down, final_norm):
    b_p = x_prompt.shape[0]
    meta = jnp.broadcast_to(meta_tokens.astype(x_prompt.dtype)[None], (b_p, N_META, D_MODEL))
    h_p = jnp.concatenate([meta, x_prompt], axis=1)
    h_s = x_sample
    conv_p_list, pool_p_list, conv_s_list, pool_s_list = [], [], [], []
    for d in range(DEPTH):
        params = (ffn1_norm[d], ffn1_w_gate[d], ffn1_w_up[d], ffn1_w_down[d],
                  mix_norm[d], w_in[d], conv_w[d], conv_b[d], conv_norm[d], pool_w[d], pool_scale[d], w_out[d],
                  ffn2_norm[d], ffn2_w_gate[d], ffn2_w_up[d], ffn2_w_down[d])
        conv_pad = jnp.zeros((b_p, CONV_K - 1, CONV_CH), h_p.dtype)
        pool_none = jnp.zeros((b_p, 0, POOL_CH), h_p.dtype)
        h_p, cp, pp = encoder_layer(h_p, conv_pad, pool_none, *params)
        h_s, cs_, ps_ = encoder_layer(h_s, state_conv[d], state_pool[d], *params)
        conv_p_list.append(cp)
        pool_p_list.append(pp)
        conv_s_list.append(cs_)
        pool_s_list.append(ps_)
    y_prompt = rmsnorm(h_p, final_norm)[:, N_META:]
    y_sample = rmsnorm(h_s, final_norm)
    new_conv_prompt = jnp.stack(conv_p_list, axis=0)
    new_pool_prompt = jnp.stack(pool_p_list, axis=0)
    new_conv_sample = jnp.stack(conv_s_list, axis=0)
    new_pool_sample = jnp.stack(pool_s_list, axis=0)
    return (y_prompt, y_sample, new_conv_prompt, new_pool_prompt, new_conv_sample, new_pool_sample)
```

```cpp
#include <hip/hip_runtime.h>
#include <hip/hip_cooperative_groups.h>
#include <cstdio>
#include <cstdint>
namespace cg = cooperative_groups;

#ifndef MK_MULTI
#define MK_MULTI 0
#endif

#ifndef PROBE_MASK
#define PROBE_MASK 0
#endif
#ifndef PROBE_SYNCS
#define PROBE_SYNCS 0
#endif
#define LAS __attribute__((address_space(3)))
typedef unsigned short bf16_t;
typedef short bf16x8 __attribute__((ext_vector_type(8)));
typedef float f32x4 __attribute__((ext_vector_type(4)));
typedef float f32x2 __attribute__((ext_vector_type(2)));
typedef unsigned u32x4 __attribute__((ext_vector_type(4)));
typedef unsigned u32x2 __attribute__((ext_vector_type(2)));

constexpr int D = 2048, DFF = 5632, CC = 1024;
constexpr int NPROMPT = 8192, NSAMP = 512, NMETA = 16;
constexpr int MR = NPROMPT + NSAMP;
constexpr int MT = MR + NMETA;
constexpr int MPAD = 8960;
constexpr float EPS = 1e-6f;

constexpr size_t O_Y = 0;
constexpr size_t O_NCP = (size_t)MR * D;
constexpr size_t O_NPP = O_NCP + 30 * CC;
constexpr size_t O_NCS = O_NPP + 15 * CC;
constexpr size_t O_NPS = O_NCS + 32 * 30 * CC;

constexpr size_t SZ_W1 = (size_t)2 * DFF * D * 2, SZ_W2 = (size_t)D * DFF * 2;
constexpr size_t WS_W1A = 0;
constexpr size_t WS_W2A = WS_W1A + SZ_W1;
constexpr size_t WS_WIN = WS_W2A + SZ_W2;
constexpr size_t WS_WOUT = WS_WIN + (size_t)3072 * D * 2;
constexpr size_t WS_WP = WS_WOUT + (size_t)D * D * 2;
constexpr size_t WS_W1B = WS_WP + (size_t)4 * 256 * 256 * 2;
constexpr size_t WS_W2B = WS_W1B + SZ_W1;
constexpr size_t WS_XN = WS_W2B + SZ_W2;
constexpr size_t WS_ACT = WS_XN + (size_t)MPAD * D * 2;
constexpr size_t WS_UC = WS_ACT;
constexpr size_t WS_UP = WS_UC + (size_t)MPAD * CC * 4;
constexpr size_t WS_PP = WS_UP + (size_t)MPAD * CC * 4;
constexpr size_t WS_H1 = WS_ACT + (size_t)MPAD * DFF * 2;
constexpr size_t WS_CTL = WS_H1 + (size_t)MPAD * D * 4;
constexpr size_t CTL_BYTES = 16384;
constexpr size_t WS_END = WS_CTL + CTL_BYTES;
static_assert(WS_PP + (size_t)MR * CC * 2 <= WS_H1, "overlay");

constexpr int LDS_BYTES = 147456;
constexpr int LDSCTL_OFF = 131072;

struct Args {
    const float* in[22];
    float* out;
    unsigned char* ws;
    int ph_lo, ph_hi;
};

__device__ __forceinline__ unsigned cvt_pk_bf16(float lo, float hi) { unsigned r; asm volatile("v_cvt_pk_bf16_f32 %0, %1, %2" : "=v"(r) : "v"(lo), "v"(hi)); return r; }
__device__ __forceinline__ float wave_sum(float v) {
#pragma unroll
    for (int o = 1; o < 64; o <<= 1) v += __shfl_xor(v, o);
    return v;
}
__device__ __forceinline__ float sigmoidf_fast(float x) { return __builtin_amdgcn_rcpf(1.0f + __builtin_amdgcn_exp2f(-1.44269504089f * x)); }

__device__ __forceinline__ const float* xrow(const float* xp, const float* xs, const float* meta, int r) {
    if (r < NPROMPT) return xp + (size_t)r * D;
    if (r < MR) return xs + (size_t)(r - NPROMPT) * D;
    if (r < MT) return meta + (size_t)(r - MR) * D;
    return nullptr;
}

namespace pg8 {
constexpr int BM = 256, BK = 64, HALF = 128, HTB = HALF * BK * 2, STAGE_BYTES = 8 * HTB, NXCD = 8, WGM = 8;
__host__ __device__ __forceinline__ int lds_byte(int r, int c) { const int st = (r >> 4) * 2 + (c >> 5), rr = r & 15, cc = c & 31, ob = rr * 64 + cc * 2; return st * 1024 + (ob ^ (((ob >> 9) & 1) << 5)); }
__host__ __device__ __forceinline__ void stage_rc(int b, int& R, int& C) { const int st = b / 1024, sb = b % 1024, swz = sb ^ (((sb >> 9) & 1) << 5); R = (st >> 1) * 16 + swz / 64; C = (st & 1) * 32 + (swz % 64) / 2; }
__host__ __device__ __forceinline__ int perm32(int rho) { const int n = rho >> 4, i = rho & 15; return 8 * (i >> 2) + 4 * n + (i & 3); }

struct Unit { const char* a; const char* b; int pm, pn, nt; };

struct TileOrder {
    const char* A; const char* Bt; size_t a_pm, a_pn, b_pn; int nM, nN, nwg, G, c, nt;
    __device__ void init(const void* A_, const void* Bt_, size_t a_pm_, size_t a_pn_, size_t b_pn_, int nM_, int nN_, int nt_, int G_, int c_) {
        A = (const char*)A_; Bt = (const char*)Bt_; a_pm = a_pm_; a_pn = a_pn_; b_pn = b_pn_; nM = nM_; nN = nN_; nwg = nM * nN; nt = nt_; G = G_; c = c_; }
    __device__ bool next(int i, Unit& u) const {
        const long L = (long)i * G + c; if (L >= nwg) return false;
        int wgid = (int)L; { const int q = nwg / NXCD, r = nwg % NXCD, xcd = wgid % NXCD, off = wgid / NXCD; wgid = (xcd < r ? xcd * (q + 1) : r * (q + 1) + (xcd - r) * q) + off; }
        const int nig = WGM * nN, gid = wgid / nig, fm = gid * WGM, gsz = (nM - fm) < WGM ? (nM - fm) : WGM;
        u.pm = fm + ((wgid % nig) % gsz); u.pn = (wgid % nig) / gsz; u.nt = nt;
        u.a = A + (size_t)u.pm * a_pm + (size_t)u.pn * a_pn; u.b = Bt + (size_t)u.pn * b_pn; return true;
    }
};

struct SplitOrder {
    const char* A; const char* Bt; size_t a_pm, b_pn; int nt, c;
    __device__ bool next(int i, Unit& u) const {
        if (i > 0) return false;
        const int xcd = c & 7, idx = c >> 3; u.pm = 4 * xcd + (idx & 3); u.pn = idx >> 2; u.nt = nt;
        u.a = A + (size_t)u.pm * a_pm; u.b = Bt + (size_t)u.pn * b_pn; return true;
    }
};
struct TailOrder {
    const char* A; const char* Bt; size_t a_pm, b_pn; int npairs, nu, nch, c;
    __device__ bool next(int i, Unit& u) const {
        if (i > 0) return false;
        const int L = (c & 7) * 32 + (c >> 3); if (L >= nu * nch) return false;
        const int t = L % nu, ch = L / nu, base = npairs / nch, rem = npairs % nch;
        const int start = ch * base + (ch < rem ? ch : rem), np = base + (ch < rem ? 1 : 0);
        u.pm = t; u.pn = ch; u.nt = 2 * np;
        u.a = A + (size_t)(32 + (t >> 3)) * a_pm + (size_t)start * 256; u.b = Bt + (size_t)(t & 7) * b_pn + (size_t)start * 256; return true;
    }
};

template <class Epi, class Sched, bool ALIGN_EPI, bool PERM>
__device__ __forceinline__ void gemm_phase(LAS unsigned char* lds, const int lda, const int ldb, const Sched& S, const Epi& E) {
    const int tid = threadIdx.x, wid = __builtin_amdgcn_readfirstlane(tid >> 6), lane = tid & 63, wr = wid >> 2, wc = wid & 3, fr = lane & 15, fq = lane >> 4;
    unsigned voffA[2], voffB[2];
#pragma unroll
    for (int i = 0; i < 2; ++i) { int R, C; stage_rc(tid * 16 + i * 8192, R, C); const int Rb = PERM ? ((R & ~31) + perm32(R & 31)) : R;
        voffA[i] = (unsigned)(R * lda + C) * 2u; voffB[i] = (unsigned)(Rb * ldb + C) * 2u; }
    const size_t kstep = (size_t)(BK * 2);
    const size_t hstepA = (size_t)HALF * lda * 2, hstepB = (size_t)HALF * ldb * 2;
    const unsigned ldsw = (unsigned)wid * 1024u;
    const int aoff = lds_byte(wr * 64 + fr, fq * 8), boff = lds_byte(wc * 32 + fr, fq * 8);
#define PG8_SA(b, h) (((b) * 2 + (h)) * HTB)
#define PG8_SB(b, h) ((4 + (b) * 2 + (h)) * HTB)
#define PG8_STAGE(bufoff, gbase, voff) do { _Pragma("unroll") for (int _i = 0; _i < 2; ++_i) \
        __builtin_amdgcn_global_load_lds((const unsigned*)((const char*)(gbase) + (voff)[_i]), (LAS unsigned*)(lds + (bufoff) + ldsw + _i * 8192), 16, 0, 0); } while (0)
#define PG8_LDA(dst, b, h) do { _Pragma("unroll") for (int m = 0; m < 4; ++m) _Pragma("unroll") for (int k = 0; k < 2; ++k) dst[m][k] = *(const LAS bf16x8*)(lds + PG8_SA(b, h) + aoff + m * 2048 + k * 1024); } while (0)
#define PG8_LDB(dst, b, h) do { _Pragma("unroll") for (int n = 0; n < 2; ++n) _Pragma("unroll") for (int k = 0; k < 2; ++k) dst[n][k] = *(const LAS bf16x8*)(lds + PG8_SB(b, h) + boff + n * 2048 + k * 1024); } while (0)
#define PG8_MMA(ai, bj, At, Bt) do { __builtin_amdgcn_s_setprio(1); _Pragma("unroll") for (int m = 0; m < 4; ++m) _Pragma("unroll") for (int n = 0; n < 2; ++n) _Pragma("unroll") for (int k = 0; k < 2; ++k) \
        acc[ai][bj][m][n] = __builtin_amdgcn_mfma_f32_16x16x32_bf16(Bt[n][k], At[m][k], acc[ai][bj][m][n], 0, 0, 0); __builtin_amdgcn_s_setprio(0); } while (0)
#define PG8_WAIT_V(n) asm volatile("s_waitcnt vmcnt(" #n ")" ::: "memory")
#define PG8_WAIT_L(n) asm volatile("s_waitcnt lgkmcnt(" #n ")" ::: "memory")
#define PG8_BAR __builtin_amdgcn_s_barrier()
#define PG8_SCHED __builtin_amdgcn_sched_barrier(0)
    Unit cur, nxt; int ui = 0;
    if (!S.next(0, cur)) return;
    f32x4 acc[2][2][4][2];
#pragma unroll
    for (int a = 0; a < 2; ++a)
#pragma unroll
        for (int b = 0; b < 2; ++b)
#pragma unroll
            for (int m = 0; m < 4; ++m)
#pragma unroll
                for (int n = 0; n < 2; ++n) acc[a][b][m][n] = (f32x4){0.f, 0.f, 0.f, 0.f};
    bf16x8 At[4][2], B0[2][2], B1[2][2];
    const char* cA = cur.a; const char* cB = cur.b;
    PG8_STAGE(PG8_SB(0, 0), cB, voffB); PG8_STAGE(PG8_SB(0, 1), cB + hstepB, voffB); PG8_STAGE(PG8_SA(0, 0), cA, voffA); PG8_STAGE(PG8_SA(0, 1), cA + hstepA, voffA);
    if (wr == 1) PG8_BAR;
    PG8_WAIT_V(2); PG8_BAR;
    PG8_STAGE(PG8_SB(1, 0), cB + kstep, voffB); PG8_STAGE(PG8_SA(1, 0), cA + kstep, voffA); PG8_STAGE(PG8_SB(1, 1), cB + hstepB + kstep, voffB);
    PG8_WAIT_V(6); PG8_BAR;
    for (;;) {
        const bool has_next = S.next(ui + 1, nxt);
        const char* nA = has_next ? nxt.a : cA; const char* nB = has_next ? nxt.b : cB;
        const int nt = cur.nt;
        for (int t = 0; t < nt; t += 2) {
            const bool last = (t == nt - 2);
            const char* a1 = cA + (size_t)(t + 1) * kstep;
            const char* a2 = last ? nA : cA + (size_t)(t + 2) * kstep; const char* b2 = last ? nB : cB + (size_t)(t + 2) * kstep;
            const char* a3 = a2 + kstep; const char* b3 = b2 + kstep;
            PG8_LDB(B0, 0, 0); PG8_LDB(B1, 0, 1); PG8_SCHED; PG8_LDA(At, 0, 0); PG8_STAGE(PG8_SA(1, 1), a1 + hstepA, voffA);
            PG8_WAIT_V(8); PG8_WAIT_L(0); PG8_BAR; PG8_MMA(0, 0, At, B0); PG8_MMA(0, 1, At, B1); PG8_BAR; PG8_SCHED;
            PG8_LDA(At, 0, 1); PG8_STAGE(PG8_SB(0, 0), b2, voffB); PG8_STAGE(PG8_SB(0, 1), b2 + hstepB, voffB); PG8_STAGE(PG8_SA(0, 0), a2, voffA);
            PG8_WAIT_V(8); PG8_WAIT_L(0); PG8_BAR; PG8_MMA(1, 0, At, B0); PG8_MMA(1, 1, At, B1); PG8_BAR; PG8_SCHED;
            PG8_LDB(B0, 1, 0); PG8_LDB(B1, 1, 1); PG8_SCHED; PG8_LDA(At, 1, 0); PG8_STAGE(PG8_SA(0, 1), a2 + hstepA, voffA);
            PG8_WAIT_V(8); PG8_WAIT_L(0); PG8_BAR; PG8_MMA(0, 0, At, B0); PG8_MMA(0, 1, At, B1); PG8_BAR; PG8_SCHED;
            PG8_LDA(At, 1, 1); PG8_STAGE(PG8_SB(1, 0), b3, voffB); PG8_STAGE(PG8_SB(1, 1), b3 + hstepB, voffB); PG8_STAGE(PG8_SA(1, 0), a3, voffA);
            PG8_WAIT_V(8); PG8_WAIT_L(0); PG8_BAR; PG8_MMA(1, 0, At, B0); PG8_MMA(1, 1, At, B1); PG8_BAR; PG8_SCHED;
        }
        if constexpr (ALIGN_EPI) { if (wr == 0) PG8_BAR; }
        E(acc, cur, wr, wc, fr, fq);
        if (!has_next) break;
#pragma unroll
        for (int a = 0; a < 2; ++a)
#pragma unroll
            for (int b = 0; b < 2; ++b)
#pragma unroll
                for (int m = 0; m < 4; ++m)
#pragma unroll
                    for (int n = 0; n < 2; ++n) acc[a][b][m][n] = (f32x4){0.f, 0.f, 0.f, 0.f};
        cur = nxt; cA = nA; cB = nB; ++ui;
        if constexpr (ALIGN_EPI) { if (wr == 1) PG8_BAR; }
    }
    PG8_WAIT_V(0);
    if constexpr (!ALIGN_EPI) { if (wr == 0) PG8_BAR; }
    PG8_BAR;
#undef PG8_SA
#undef PG8_SB
#undef PG8_STAGE
#undef PG8_LDA
#undef PG8_LDB
#undef PG8_MMA
#undef PG8_WAIT_V
#undef PG8_WAIT_L
#undef PG8_BAR
#undef PG8_SCHED
}
}

struct EpiSwiglu {
    bf16_t* O;
    __device__ __forceinline__ void operator()(const f32x4 (&acc)[2][2][4][2], const pg8::Unit& u, int wr, int wc, int fr, int fq) const {
        const int row0 = u.pm * 256 + wr * 64 + fr, col0 = u.pn * 128 + wc * 32 + 8 * fq;
#pragma unroll
        for (int ai = 0; ai < 2; ++ai)
#pragma unroll
            for (int m = 0; m < 4; ++m) {
                bf16_t* rowp = O + (size_t)(row0 + ai * 128 + m * 16) * DFF + col0;
                float o[8];
#pragma unroll
                for (int n = 0; n < 2; ++n)
#pragma unroll
                    for (int j = 0; j < 4; ++j) { const float g = acc[ai][0][m][n][j], up = acc[ai][1][m][n][j]; o[4 * n + j] = g * sigmoidf_fast(g) * up; }
                u32x4 w; w.x = cvt_pk_bf16(o[0], o[1]); w.y = cvt_pk_bf16(o[2], o[3]); w.z = cvt_pk_bf16(o[4], o[5]); w.w = cvt_pk_bf16(o[6], o[7]);
                *(u32x4*)rowp = w;
            }
    }
};
template <bool XMODE> struct EpiResid {
    const float* base; const float* xs; const float* meta; float* out; float scale;
    __device__ __forceinline__ void operator()(const f32x4 (&acc)[2][2][4][2], const pg8::Unit& u, int wr, int wc, int fr, int fq) const {
        const int row0 = u.pm * 256 + wr * 64 + fr, col0 = u.pn * 256 + wc * 32 + 4 * fq;
#pragma unroll
        for (int ai = 0; ai < 2; ++ai)
#pragma unroll
            for (int m = 0; m < 4; ++m) {
                const int r = row0 + ai * 128 + m * 16;
                const float* bp = XMODE ? xrow(base, xs, meta, r) : base + (size_t)r * D;
                float* op = out + (size_t)r * D + col0;
#pragma unroll
                for (int bj = 0; bj < 2; ++bj)
#pragma unroll
                    for (int n = 0; n < 2; ++n) {
                        f32x4 bv = (f32x4){0.f, 0.f, 0.f, 0.f};
                        if (!XMODE || bp) bv = *(const f32x4*)(bp + col0 + bj * 128 + n * 16);
                        *(f32x4*)(op + bj * 128 + n * 16) = bv + acc[ai][bj][m][n] * scale;
                    }
            }
    }
};
struct EpiGluPool {
    float* UC; float* UP;
    __device__ __forceinline__ void operator()(const f32x4 (&acc)[2][2][4][2], const pg8::Unit& u, int wr, int wc, int fr, int fq) const {
        const int row0 = u.pm * 256 + wr * 64 + fr;
        if (u.pn < 8) {
            const int col0 = u.pn * 128 + wc * 32 + 4 * fq;
#pragma unroll
            for (int ai = 0; ai < 2; ++ai)
#pragma unroll
                for (int m = 0; m < 4; ++m) {
                    float* op = UC + (size_t)(row0 + ai * 128 + m * 16) * CC + col0;
#pragma unroll
                    for (int n = 0; n < 2; ++n) {
                        const f32x4 a = acc[ai][0][m][n], g = acc[ai][1][m][n]; f32x4 o;
#pragma unroll
                        for (int j = 0; j < 4; ++j) o[j] = a[j] * sigmoidf_fast(g[j]);
                        *(f32x4*)(op + n * 16) = o;
                    }
                }
        } else {
            const int col0 = (u.pn - 8) * 256 + wc * 32 + 4 * fq;
#pragma unroll
            for (int ai = 0; ai < 2; ++ai)
#pragma unroll
                for (int m = 0; m < 4; ++m) {
                    float* op = UP + (size_t)(row0 + ai * 128 + m * 16) * CC + col0;
#pragma unroll
                    for (int bj = 0; bj < 2; ++bj)
#pragma unroll
                        for (int n = 0; n < 2; ++n) *(f32x4*)(op + bj * 128 + n * 16) = acc[ai][bj][m][n];
                }
        }
    }
};
struct EpiPool {
    bf16_t* MIX; const float* scale;
    __device__ __forceinline__ void operator()(const f32x4 (&acc)[2][2][4][2], const pg8::Unit& u, int wr, int wc, int fr, int fq) const {
        const int row0 = u.pm * 256 + wr * 64 + fr, c0 = u.pn * 256 + wc * 32 + 8 * fq;
        f32x4 sv[2][2];
#pragma unroll
        for (int bj = 0; bj < 2; ++bj)
#pragma unroll
            for (int n = 0; n < 2; ++n) sv[bj][n] = *(const f32x4*)(scale + c0 + bj * 128 + 4 * n);
#pragma unroll
        for (int ai = 0; ai < 2; ++ai)
#pragma unroll
            for (int m = 0; m < 4; ++m) {
                bf16_t* rowp = MIX + (size_t)(row0 + ai * 128 + m * 16) * 2048 + 1024 + c0;
#pragma unroll
                for (int bj = 0; bj < 2; ++bj) {
                    const f32x4 v0 = acc[ai][bj][m][0] * sv[bj][0], v1 = acc[ai][bj][m][1] * sv[bj][1];
                    u32x4 w; w.x = cvt_pk_bf16(v0[0], v0[1]); w.y = cvt_pk_bf16(v0[2], v0[3]); w.z = cvt_pk_bf16(v1[0], v1[1]); w.w = cvt_pk_bf16(v1[2], v1[3]);
                    *(u32x4*)(rowp + bj * 128) = w;
                }
            }
    }
};

struct EpiPartial {
    float* part; int nch;
    __device__ __forceinline__ void operator()(const f32x4 (&acc)[2][2][4][2], const pg8::Unit& u, int wr, int wc, int fr, int fq) const {
        float* tp = part + ((size_t)(u.pm * nch + u.pn) << 16) + (size_t)(wr * 64 + fr) * 256 + wc * 32 + 4 * fq;
#pragma unroll
        for (int ai = 0; ai < 2; ++ai)
#pragma unroll
            for (int m = 0; m < 4; ++m)
#pragma unroll
                for (int bj = 0; bj < 2; ++bj)
#pragma unroll
                    for (int n = 0; n < 2; ++n) *(f32x4*)(tp + (ai * 128 + m * 16) * 256 + bj * 128 + n * 16) = acc[ai][bj][m][n];
    }
};
template <bool FINAL> __device__ __forceinline__ void heavy_row(const float* base_row, float scale, const float* part, int nch, int trow, int lr, const float* g, float* hout, bf16_t* xn, int lane) {
    f32x4 v[8];
#pragma unroll
    for (int j = 0; j < 8; ++j) v[j] = (f32x4){0.f, 0.f, 0.f, 0.f};
    const float* pp = part + (size_t)lr * 256 + 4 * lane;
    for (int c = 0; c < nch; ++c) {
#pragma unroll
        for (int j = 0; j < 8; ++j) v[j] += *(const f32x4*)(pp + ((size_t)((trow * 8 + j) * nch + c) << 16));
    }
    float s = 0.f;
#pragma unroll
    for (int j = 0; j < 8; ++j) {
        f32x4 b = (f32x4){0.f, 0.f, 0.f, 0.f};
        if (base_row) b = *((const f32x4*)base_row + lane + 64 * j);
        v[j] = b + v[j] * scale;
        s += (v[j].x * v[j].x + v[j].y * v[j].y) + (v[j].z * v[j].z + v[j].w * v[j].w);
    }
    const float rs = rsqrtf(wave_sum(s) * (1.f / D) + EPS);
    const f32x4* gr = (const f32x4*)g + lane;
#pragma unroll
    for (int j = 0; j < 8; ++j) {
        const f32x4 gv = gr[64 * j]; const f32x4 y = v[j] * rs * gv;
        if (FINAL) { *((f32x4*)hout + lane + 64 * j) = y; }
        else { *((f32x4*)hout + lane + 64 * j) = v[j]; *((u32x2*)xn + lane + 64 * j) = (u32x2){cvt_pk_bf16(y.x, y.y), cvt_pk_bf16(y.z, y.w)}; }
    }
}

template <int N, int K> __device__ __forceinline__ void cvt_item(const float* __restrict__ src, bf16_t* __restrict__ dst, int item, int mode, int lane) {
    constexpr int NB = N / 64;
    const int kb = item / NB, nb = item % NB, n0 = nb * 64, k0 = kb * 64;
    int row0;
    if (mode == 0) row0 = n0;
    else if (mode == 1) row0 = 256 * (n0 >> 7) + (n0 & 127);
    else if (mode == 2) row0 = 256 * (n0 >> 7) + 128 + (n0 & 127);
    else row0 = n0 < 1024 ? 256 * (n0 >> 7) + (n0 & 127) : (n0 < 2048 ? 256 * ((n0 - 1024) >> 7) + 128 + ((n0 - 1024) & 127) : n0);
    const float* s = src + (size_t)k0 * N + n0 + lane;
    bf16_t* d = dst + (size_t)(row0 + lane) * K + k0;
#pragma unroll
    for (int h = 0; h < 2; ++h) {
        float v[32];
#pragma unroll
        for (int i = 0; i < 32; ++i) v[i] = s[(size_t)(h * 32 + i) * N];
#pragma unroll
        for (int q = 0; q < 4; ++q) {
            u32x4 w; w.x = cvt_pk_bf16(v[8 * q], v[8 * q + 1]); w.y = cvt_pk_bf16(v[8 * q + 2], v[8 * q + 3]); w.z = cvt_pk_bf16(v[8 * q + 4], v[8 * q + 5]); w.w = cvt_pk_bf16(v[8 * q + 6], v[8 * q + 7]);
            *(u32x4*)(d + h * 32 + q * 8) = w;
        }
    }
}

__device__ __forceinline__ void norm_row_bf16(const float* src, const float* g, bf16_t* dst, int lane) {
    u32x2* o8 = (u32x2*)dst + lane;
    if (!src) {
#pragma unroll
        for (int j = 0; j < 8; ++j) o8[64 * j] = (u32x2){0u, 0u};
        return;
    }
    const f32x4* xr = (const f32x4*)src + lane; const f32x4* gr = (const f32x4*)g + lane;
    f32x4 v[8]; float s = 0.f;
#pragma unroll
    for (int j = 0; j < 8; ++j) { v[j] = xr[64 * j]; s += (v[j].x * v[j].x + v[j].y * v[j].y) + (v[j].z * v[j].z + v[j].w * v[j].w); }
    const float rs = rsqrtf(wave_sum(s) * (1.f / D) + EPS);
#pragma unroll
    for (int j = 0; j < 8; ++j) { const f32x4 gv = gr[64 * j]; const f32x4 y = v[j] * rs * gv; o8[64 * j] = (u32x2){cvt_pk_bf16(y.x, y.y), cvt_pk_bf16(y.z, y.w)}; }
}
__device__ __forceinline__ void norm_row_f32_inplace(float* row, const float* g, int lane) {
    f32x4* xr = (f32x4*)row + lane; const f32x4* gr = (const f32x4*)g + lane;
    f32x4 v[8]; float s = 0.f;
#pragma unroll
    for (int j = 0; j < 8; ++j) { v[j] = xr[64 * j]; s += (v[j].x * v[j].x + v[j].y * v[j].y) + (v[j].z * v[j].z + v[j].w * v[j].w); }
    const float rs = rsqrtf(wave_sum(s) * (1.f / D) + EPS);
#pragma unroll
    for (int j = 0; j < 8; ++j) { const f32x4 gv = gr[64 * j]; xr[64 * j] = v[j] * rs * gv; }
}

__device__ __forceinline__ const float* conv_src_row(int it, int e, const float* UC, const float* sc, bool& ok) {
    const int p = 16 * it - 14 + e, b = it - 512;
    const size_t rp = (size_t)(p < 16 ? (p < 0 ? 0 : MR + p) : p - 16);
    const float* a0 = UC + rp * CC;
    const float* a1 = e < 30 ? sc + (size_t)(b * 30 + e) * CC : UC + (size_t)(NPROMPT + 16 * b + e - 30) * CC;
    ok = (it >= 512) || (p >= 0);
    return it < 512 ? a0 : a1;
}
__device__ __forceinline__ const float* pool_src_row(int it, int e, const float* UP, const float* sp) {
    const int p = 16 * it + 1 + e, b = it - 512;
    const float* a0 = UP + (size_t)(p < 16 ? MR + p : p - 16) * CC;
    const float* a1 = e < 15 ? sp + (size_t)(b * 15 + e) * CC : UP + (size_t)(NPROMPT + 16 * b + e - 15) * CC;
    return it < 512 ? a0 : a1;
}
__device__ __forceinline__ void mixer_item(int it, const float* UC, const float* UP, const float* sc, const float* sp, const float* conv_w, const float* conv_b, const float* conv_norm,
                                           bf16_t* MIX, bf16_t* PP, float* out, const LAS float* wl, LAS float* red, int tid) {
    const int lane = tid & 63, wave = tid >> 6, ch = 2 * tid;
    const bool wstate = (it >= 511);
    float* ncv = out + (it == 511 ? O_NCP : O_NCS + (size_t)(it - 512) * 30 * CC);
    float* npl = out + (it == 511 ? O_NPP : O_NPS + (size_t)(it - 512) * 15 * CC);
    f32x2 ext[46];
#pragma unroll
    for (int e = 0; e < 46; ++e) {
        bool ok; const float* rp = conv_src_row(it, e, UC, sc, ok);
        const f32x2 v = *(const f32x2*)(rp + ch);
        ext[e] = ok ? v : (f32x2){0.f, 0.f};
    }
    const f32x2 bias = *(const f32x2*)(conv_b + ch);
    if (wstate) {
#pragma unroll
        for (int i = 0; i < 30; ++i) *(f32x2*)(ncv + (size_t)i * CC + ch) = ext[16 + i];
    }
    f32x2 y[16];
#pragma unroll
    for (int t = 0; t < 16; ++t) y[t] = bias;
#pragma unroll
    for (int j = 0; j < 31; ++j) {
        const f32x2 wj = *(const LAS f32x2*)(wl + j * CC + ch);
#pragma unroll
        for (int t = 0; t < 16; ++t) y[t] += wj * ext[t + j];
    }
    float ss[16];
#pragma unroll
    for (int t = 0; t < 16; ++t) ss[t] = wave_sum(y[t].x * y[t].x + y[t].y * y[t].y);
    __syncthreads();
    if (lane == 0) {
#pragma unroll
        for (int t = 0; t < 16; ++t) red[wave * 16 + t] = ss[t];
    }
    __syncthreads();
    const f32x2 gcn = *(const f32x2*)(conv_norm + ch);
#pragma unroll
    for (int t = 0; t < 16; ++t) {
        float s = 0.f;
#pragma unroll
        for (int q = 0; q < 8; ++q) s += red[q * 16 + t];
        const float rs = rsqrtf(s * (1.f / CC) + EPS);
        const float a = y[t].x * rs * gcn.x, b = y[t].y * rs * gcn.y;
        const float ca = a * sigmoidf_fast(a), cb = b * sigmoidf_fast(b);
        *(unsigned*)(MIX + (size_t)(16 * it + t) * 2048 + ch) = cvt_pk_bf16(ca, cb);
    }
    const int wwin = 2 << (tid >> 7);
    const float inv = 1.0f / (float)wwin;
    f32x2 x[31];
#pragma unroll
    for (int e = 0; e < 31; ++e) { const float* rp = pool_src_row(it, e, UP, sp); x[e] = *(const f32x2*)(rp + ch); }
    if (wstate) {
#pragma unroll
        for (int i = 0; i < 15; ++i) *(f32x2*)(npl + (size_t)i * CC + ch) = x[16 + i];
    }
#pragma unroll
    for (int t = 0; t < 16; ++t) {
        f32x2 s = (f32x2){0.f, 0.f};
#pragma unroll
        for (int k = 0; k < 16; ++k) { const f32x2 xv = x[15 + t - k]; s += (k < wwin) ? xv : (f32x2){0.f, 0.f}; }
        const f32x2 p = s * inv - x[15 + t];
        *(unsigned*)(PP + (size_t)(16 * it + t) * CC + ch) = cvt_pk_bf16(p.x, p.y);
    }
}

__device__ __forceinline__ void thin_swiglu_unit(const bf16_t* A, const bf16_t* Bt, int pn, bf16_t* ACT, int wave, int lane) {
    const int fr = lane & 15, fq = lane >> 4;
    const bf16x8* ap = (const bf16x8*)(A + (size_t)fr * D + 8 * fq);
    const bf16x8* gp = (const bf16x8*)(Bt + (size_t)(256 * pn + 16 * wave + fr) * D + 8 * fq);
    const bf16x8* up = (const bf16x8*)(Bt + (size_t)(256 * pn + 128 + 16 * wave + fr) * D + 8 * fq);
    f32x4 ag = (f32x4){0.f, 0.f, 0.f, 0.f}, au = (f32x4){0.f, 0.f, 0.f, 0.f};
    for (int k0 = 0; k0 < D / 32; k0 += 8) {
        bf16x8 a[8], g[8], u[8];
#pragma unroll
        for (int i = 0; i < 8; ++i) { a[i] = ap[(k0 + i) * 4]; g[i] = gp[(k0 + i) * 4]; u[i] = up[(k0 + i) * 4]; }
#pragma unroll
        for (int i = 0; i < 8; ++i) {
            ag = __builtin_amdgcn_mfma_f32_16x16x32_bf16(g[i], a[i], ag, 0, 0, 0);
            au = __builtin_amdgcn_mfma_f32_16x16x32_bf16(u[i], a[i], au, 0, 0, 0);
        }
    }
    float o[4];
#pragma unroll
    for (int j = 0; j < 4; ++j) o[j] = ag[j] * sigmoidf_fast(ag[j]) * au[j];
    *(u32x2*)(ACT + (size_t)(MR + fr) * DFF + 128 * pn + 16 * wave + 4 * fq) = (u32x2){cvt_pk_bf16(o[0], o[1]), cvt_pk_bf16(o[2], o[3])};
}

#define XB_TMO      128
#define XB_XCNT(j)  (256  + 64 * (j))
#define XB_XSUB(j)  (1280 + 64 * (j))
#define XB_XGEN(j)  (2304 + 64 * (j))
#define XB_TOP      3328
#define XB_TOPGEN   3392
#define XCD_BAR_WORDS 3456
#define XB_SPIN_CAP (1u << 18)

__device__ __forceinline__ unsigned xb_ld(unsigned* p)              { return __hip_atomic_load(p, __ATOMIC_RELAXED, __HIP_MEMORY_SCOPE_AGENT); }
__device__ __forceinline__ unsigned xb_add(unsigned* p, unsigned v) { return __hip_atomic_fetch_add(p, v, __ATOMIC_RELAXED, __HIP_MEMORY_SCOPE_AGENT); }
__device__ __forceinline__ unsigned xb_xcc_id() { return (unsigned)__builtin_amdgcn_s_getreg((3 << 11) | 20) & 0xFu; }
#define XB_SPIN(cond, bar) do { unsigned _sp = 0; while (cond) { __builtin_amdgcn_s_sleep(1); \
    if ((++_sp & 255u) == 0u) { if (xb_ld(&(bar)[XB_TMO])) break; if (_sp > XB_SPIN_CAP) { atomicAdd(&(bar)[XB_TMO], 1u); break; } } } } while (0)

struct XcdBarrier {
    unsigned* bar; unsigned x;
    volatile LAS unsigned* st;
};

__device__ __forceinline__ XcdBarrier xcd_barrier_post(unsigned* bar, volatile LAS unsigned* st) {
    XcdBarrier b; b.bar = bar; b.x = xb_xcc_id(); b.st = st;
    if (threadIdx.x == 0) (void)xb_add(&bar[XB_XCNT(b.x)], 1u);
    return b;
}
__device__ __forceinline__ void xcd_barrier_complete(unsigned* bar, unsigned x, unsigned& nloc, unsigned& nx) {
    const unsigned G = gridDim.x * gridDim.y * gridDim.z;
    unsigned sum, cnt, mine, sp = 0u;
    for (;;) {
        sum = 0u; cnt = 0u; mine = 0u;
#pragma unroll
        for (unsigned j = 0; j < 16; ++j) { const unsigned c = xb_ld(&bar[XB_XCNT(j)]); sum += c; cnt += (c > 0u) ? 1u : 0u; mine = (j == x) ? c : mine; }
        if (sum == G) break;
        __builtin_amdgcn_s_sleep(1);
        if ((++sp & 255u) == 0u) { if (xb_ld(&bar[XB_TMO])) break; if (sp > XB_SPIN_CAP) { atomicAdd(&bar[XB_TMO], 1u); break; } }
    }
    nloc = mine > 0u ? mine : 1u; nx = cnt > 0u ? cnt : 1u;
}

__device__ __forceinline__ void xcd_barrier(const XcdBarrier& b) {
    asm volatile("s_waitcnt vmcnt(0)" ::: "memory");
    __syncthreads();
    if (threadIdx.x == 0) {
        unsigned* bar = b.bar;
        __builtin_amdgcn_s_waitcnt(0);
        unsigned nloc = b.st[0], nx = b.st[1];
        if (nloc == 0u) { xcd_barrier_complete(bar, b.x, nloc, nx); b.st[0] = nloc; b.st[1] = nx; }
        const unsigned old = xb_add(&bar[XB_XSUB(b.x)], 1u);
        const unsigned gen = old / nloc;
        if (old + 1u == (gen + 1u) * nloc) {
            __builtin_amdgcn_fence(__ATOMIC_RELEASE, "agent");
            asm volatile("s_waitcnt vmcnt(0)" ::: "memory");
            const unsigned og = xb_add(&bar[XB_TOP], 1u);
            const unsigned tg = og / nx;
            if (og + 1u == (tg + 1u) * nx) xb_add(&bar[XB_TOPGEN], 1u);
            else XB_SPIN(xb_ld(&bar[XB_TOPGEN]) == tg, bar);
            __builtin_amdgcn_fence(__ATOMIC_ACQUIRE, "agent");
            xb_add(&bar[XB_XGEN(b.x)], 1u);
            asm volatile("s_waitcnt vmcnt(0)" ::: "memory");
        } else {
            XB_SPIN(xb_ld(&bar[XB_XGEN(b.x)]) == gen, bar);
            __builtin_amdgcn_fence(__ATOMIC_ACQUIRE, "agent");
            asm volatile("s_waitcnt vmcnt(0)" ::: "memory");
        }
    }
    __syncthreads();
}

constexpr int N_PHASES = 12;
__global__ void __launch_bounds__(512, 2) mk_fwd(Args args) {
    extern __shared__ __attribute__((aligned(16))) unsigned char lds_raw[];
    LAS unsigned char* lds = (LAS unsigned char*)lds_raw;
    cg::grid_group grid = cg::this_grid();
    const int tid = threadIdx.x, lane = tid & 63, wave = __builtin_amdgcn_readfirstlane(tid >> 6);
    const int G = gridDim.x, bx = blockIdx.x;
    const int gw = bx * 8 + wave, NGW = G * 8;
    unsigned char* ws = args.ws;
    const float* x_prompt = args.in[0]; const float* x_sample = args.in[1]; const float* state_conv = args.in[2]; const float* state_pool = args.in[3]; const float* meta = args.in[4];
    const float* ffn1_norm = args.in[5]; const float* mix_norm = args.in[9]; const float* conv_w = args.in[11]; const float* conv_b = args.in[12]; const float* conv_norm = args.in[13];
    const float* pool_scale = args.in[15]; const float* ffn2_norm = args.in[17]; const float* final_norm = args.in[21];
    bf16_t* W1A = (bf16_t*)(ws + WS_W1A); bf16_t* W2A = (bf16_t*)(ws + WS_W2A); bf16_t* WIN = (bf16_t*)(ws + WS_WIN); bf16_t* WOUT = (bf16_t*)(ws + WS_WOUT); bf16_t* WP = (bf16_t*)(ws + WS_WP);
    bf16_t* W1B = (bf16_t*)(ws + WS_W1B); bf16_t* W2B = (bf16_t*)(ws + WS_W2B);
    bf16_t* XN = (bf16_t*)(ws + WS_XN); bf16_t* MIX = XN; bf16_t* ACT = (bf16_t*)(ws + WS_ACT);
    float* UC = (float*)(ws + WS_UC); float* UP = (float*)(ws + WS_UP); bf16_t* PP = (bf16_t*)(ws + WS_PP);
    float* H1 = (float*)(ws + WS_H1); float* H2 = args.out + O_Y;
    float* PART_A = args.out;
    float* PART_B = (float*)(ws + WS_ACT);
    float* PART_C = H1;
    const int lo = args.ph_lo, hi = args.ph_hi;
    for (int u = tid; u < (LDS_BYTES - LDSCTL_OFF) / 4; u += 512) ((LAS unsigned*)(lds + LDSCTL_OFF))[u] = 0u;
    __syncthreads();
    XcdBarrier bar = xcd_barrier_post((unsigned*)(ws + WS_CTL), (volatile LAS unsigned*)(lds + LDSCTL_OFF + 64));
    if (lo == -12345) grid.sync();
#define IN(k) (lo <= (k) && (k) < hi)
#define REP(k) for (int rep_ = 0; rep_ < 1 + ((PROBE_MASK >> (k)) & 1); ++rep_)
#define SEAM(k) do { if (IN(k) && IN((k) + 1)) xcd_barrier(bar); } while (0)

    for (int i_ = 0; i_ < PROBE_SYNCS; ++i_) xcd_barrier(bar);
    if (IN(0)) REP(0) {
        constexpr int I_F = 32 * 88, I_IN = 32 * 48, I_OUT = 32 * 32, I_P = 16;
        constexpr int NITEMS = 6 * I_F + I_IN + I_OUT + 4 * I_P;
        for (int it = gw; it < NITEMS; it += NGW) {
            int r = it;
            if (r < I_F) { cvt_item<DFF, D>(args.in[6], W1A, r, 1, lane); continue; } r -= I_F;
            if (r < I_F) { cvt_item<DFF, D>(args.in[7], W1A, r, 2, lane); continue; } r -= I_F;
            if (r < I_F) { cvt_item<D, DFF>(args.in[8], W2A, r, 0, lane); continue; } r -= I_F;
            if (r < I_IN) { cvt_item<3072, D>(args.in[10], WIN, r, 3, lane); continue; } r -= I_IN;
            if (r < I_OUT) { cvt_item<D, D>(args.in[16], WOUT, r, 0, lane); continue; } r -= I_OUT;
            if (r < I_F) { cvt_item<DFF, D>(args.in[18], W1B, r, 1, lane); continue; } r -= I_F;
            if (r < I_F) { cvt_item<DFF, D>(args.in[19], W1B, r, 2, lane); continue; } r -= I_F;
            if (r < I_F) { cvt_item<D, DFF>(args.in[20], W2B, r, 0, lane); continue; } r -= I_F;
            const int g = r / I_P; cvt_item<256, 256>(args.in[14] + (size_t)g * 65536, WP + (size_t)g * 65536, r % I_P, 0, lane);
        }
        for (int m = gw; m < MPAD; m += NGW) norm_row_bf16(xrow(x_prompt, x_sample, meta, m), ffn1_norm, XN + (size_t)m * D, lane);
    }
    SEAM(0);
    if (IN(1)) REP(1) {
        pg8::TileOrder S; S.init(XN, W1A, (size_t)256 * D * 2, 0, (size_t)256 * D * 2, MR / 256, 2 * DFF / 256, D / 64, G, bx);
        EpiSwiglu E{ACT};
        pg8::gemm_phase<EpiSwiglu, pg8::TileOrder, true, true>(lds, D, D, S, E);
        const int nfull = (MR / 256) * (2 * DFF / 256) % G, nidle = G - nfull;
        if (bx >= nfull) for (int j = bx - nfull; j < 2 * DFF / 256; j += nidle) thin_swiglu_unit(XN + (size_t)MR * D, W1A, j, ACT, wave, lane);
    }
    SEAM(1);
    if (IN(2)) REP(2) {
        {   pg8::SplitOrder S{(const char*)ACT, (const char*)W2A, (size_t)256 * DFF * 2, (size_t)256 * DFF * 2, DFF / 64, bx};
            EpiResid<true> E{x_prompt, x_sample, meta, H1, 0.5f};
            pg8::gemm_phase<EpiResid<true>, pg8::SplitOrder, false, false>(lds, DFF, DFF, S, E); }
        {   pg8::TailOrder S{(const char*)ACT, (const char*)W2A, (size_t)256 * DFF * 2, (size_t)256 * DFF * 2, DFF / 128, 24, 10, bx};
            EpiPartial E{PART_A, 10};
            pg8::gemm_phase<EpiPartial, pg8::TailOrder, false, false>(lds, DFF, DFF, S, E); }
    }
    SEAM(2);
    if (IN(3)) REP(3) {
        for (int m = gw; m < NPROMPT; m += NGW) norm_row_bf16(H1 + (size_t)m * D, mix_norm, XN + (size_t)m * D, lane);
        for (int h = wave * G + bx; h < MPAD - NPROMPT; h += 8 * G) {
            const int m = NPROMPT + h;
            if (m < MT) heavy_row<false>(xrow(x_prompt, x_sample, meta, m), 0.5f, PART_A, 10, h >> 8, h & 255, mix_norm, H1 + (size_t)m * D, XN + (size_t)m * D, lane);
            else norm_row_bf16(nullptr, mix_norm, XN + (size_t)m * D, lane);
        }
    }
    SEAM(3);
    if (IN(4)) REP(4) {
        pg8::TileOrder S; S.init(XN, WIN, (size_t)256 * D * 2, 0, (size_t)256 * D * 2, MPAD / 256, 3072 / 256, D / 64, G, bx);
        EpiGluPool E{UC, UP};
        pg8::gemm_phase<EpiGluPool, pg8::TileOrder, true, false>(lds, D, D, S, E);
    }
    SEAM(4);
    if (IN(5)) REP(5) {
        LAS float* wl = (LAS float*)lds;
        for (int i = tid; i < 31 * CC / 4; i += 512) *((LAS f32x4*)wl + i) = *((const f32x4*)conv_w + i);
        __syncthreads();
        for (int it = bx; it < 544; it += G)
            mixer_item(it, UC, UP, state_conv, state_pool, conv_w, conv_b, conv_norm, MIX, PP, args.out, wl, wl + 31 * CC, tid);
        __syncthreads();
    }
    SEAM(5);
    if (IN(6)) REP(6) {
        pg8::TileOrder S; S.init(PP, WP, (size_t)256 * CC * 2, (size_t)256 * 2, (size_t)256 * 256 * 2, MR / 256, 4, 256 / 64, G, bx);
        EpiPool E{MIX, pool_scale};
        pg8::gemm_phase<EpiPool, pg8::TileOrder, true, true>(lds, CC, 256, S, E);
    }
    SEAM(6);
    if (IN(7)) REP(7) {
        {   pg8::SplitOrder S{(const char*)MIX, (const char*)WOUT, (size_t)256 * D * 2, (size_t)256 * D * 2, D / 64, bx};
            EpiResid<false> E{H1, nullptr, nullptr, H2, 1.0f};
            pg8::gemm_phase<EpiResid<false>, pg8::SplitOrder, false, false>(lds, D, D, S, E); }
        {   pg8::TailOrder S{(const char*)MIX, (const char*)WOUT, (size_t)256 * D * 2, (size_t)256 * D * 2, D / 128, 16, 16, bx};
            EpiPartial E{PART_B, 16};
            pg8::gemm_phase<EpiPartial, pg8::TailOrder, false, false>(lds, D, D, S, E); }
    }
    SEAM(7);
    if (IN(8)) REP(8) {
        for (int m = gw; m < NPROMPT; m += NGW) norm_row_bf16(H2 + (size_t)m * D, ffn2_norm, XN + (size_t)m * D, lane);
        for (int h = wave * G + bx; h < NSAMP; h += 8 * G) {
            const int m = NPROMPT + h;
            heavy_row<false>(H1 + (size_t)m * D, 1.0f, PART_B, 16, h >> 8, h & 255, ffn2_norm, H2 + (size_t)m * D, XN + (size_t)m * D, lane);
        }
    }
    SEAM(8);
    if (IN(9)) REP(9) {
        pg8::TileOrder S; S.init(XN, W1B, (size_t)256 * D * 2, 0, (size_t)256 * D * 2, MR / 256, 2 * DFF / 256, D / 64, G, bx);
        EpiSwiglu E{ACT};
        pg8::gemm_phase<EpiSwiglu, pg8::TileOrder, true, true>(lds, D, D, S, E);
    }
    SEAM(9);
    if (IN(10)) REP(10) {
        {   pg8::SplitOrder S{(const char*)ACT, (const char*)W2B, (size_t)256 * DFF * 2, (size_t)256 * DFF * 2, DFF / 64, bx};
            EpiResid<false> E{H2, nullptr, nullptr, H2, 0.5f};
            pg8::gemm_phase<EpiResid<false>, pg8::SplitOrder, false, false>(lds, DFF, DFF, S, E); }
        {   pg8::TailOrder S{(const char*)ACT, (const char*)W2B, (size_t)256 * DFF * 2, (size_t)256 * DFF * 2, DFF / 128, 16, 16, bx};
            EpiPartial E{PART_C, 16};
            pg8::gemm_phase<EpiPartial, pg8::TailOrder, false, false>(lds, DFF, DFF, S, E); }
    }
    SEAM(10);
    if (IN(11)) REP(11) {
        for (int m = gw; m < NPROMPT; m += NGW) norm_row_f32_inplace(H2 + (size_t)m * D, final_norm, lane);
        for (int h = wave * G + bx; h < NSAMP; h += 8 * G) {
            const int m = NPROMPT + h;
            heavy_row<true>(H2 + (size_t)m * D, 0.5f, PART_C, 16, h >> 8, h & 255, final_norm, H2 + (size_t)m * D, nullptr, lane);
        }
    }
#undef IN
#undef SEAM
}

extern "C" void kernel_launch(void* const* d_in, const int* in_sizes, int n_in, void* d_out, int out_size, void* d_ws, size_t ws_size, hipStream_t stream) {
    static int grid = 0;
    if (grid == 0) {
        if (n_in != 22 || ws_size < WS_END) { fprintf(stderr, "kernel_launch: unexpected n_in %d / ws_size %zu (need %zu)\n", n_in, ws_size, (size_t)WS_END); grid = -1; return; }
        int dev = 0, cus = 0, per_cu = 0;
        (void)hipGetDevice(&dev); (void)hipDeviceGetAttribute(&cus, hipDeviceAttributeMultiprocessorCount, dev);
        if (hipFuncSetAttribute((const void*)mk_fwd, hipFuncAttributeMaxDynamicSharedMemorySize, LDS_BYTES) != hipSuccess) { fprintf(stderr, "kernel_launch: hipFuncSetAttribute failed\n"); grid = -1; return; }
        if (hipOccupancyMaxActiveBlocksPerMultiprocessor(&per_cu, (const void*)mk_fwd, 512, LDS_BYTES) != hipSuccess || per_cu < 1) { fprintf(stderr, "kernel_launch: occupancy query says %d\n", per_cu); per_cu = 1; }
        (void)hipGetLastError();
        grid = cus * 1;
        if (grid <= 0) grid = 256;
    }
    if (grid < 0) return;
    if (hipMemsetAsync((char*)d_ws + WS_CTL, 0, CTL_BYTES, stream) != hipSuccess) { fprintf(stderr, "kernel_launch: memset of the barrier words failed\n"); return; }
    Args a{};
    for (int i = 0; i < 22; ++i) a.in[i] = (const float*)d_in[i];
    a.out = (float*)d_out; a.ws = (unsigned char*)d_ws;
#if MK_MULTI
    for (int p = 0; p < N_PHASES; ++p) { a.ph_lo = p; a.ph_hi = p + 1; hipLaunchKernelGGL(mk_fwd, dim3(grid), dim3(512), LDS_BYTES, stream, a); }
#else
    a.ph_lo = 0; a.ph_hi = N_PHASES;
    void* kargs[] = {&a};
    hipError_t e = hipLaunchCooperativeKernel((const void*)mk_fwd, dim3(grid), dim3(512), kargs, LDS_BYTES, stream);
    if (e != hipSuccess) fprintf(stderr, "kernel_launch: cooperative launch failed: %s (grid %d)\n", hipGetErrorString(e), grid);
#endif
}
```

```cpp
#include <hip/hip_runtime.h>
#include <hip/hip_cooperative_groups.h>
#include <cstdio>
#include <cstdint>
namespace cg = cooperative_groups;

#ifndef MK_MULTI
#define MK_MULTI 0
#endif

#ifndef PROBE_MASK
#define PROBE_MASK 0
#endif
#ifndef PROBE_SYNCS
#define PROBE_SYNCS 0
#endif
#define LAS __attribute__((address_space(3)))
typedef unsigned short bf16_t;
typedef short bf16x8 __attribute__((ext_vector_type(8)));
typedef float f32x4 __attribute__((ext_vector_type(4)));
typedef float f32x2 __attribute__((ext_vector_type(2)));
typedef unsigned u32x4 __attribute__((ext_vector_type(4)));
typedef unsigned u32x2 __attribute__((ext_vector_type(2)));

constexpr int D = 2048, DFF = 5632, CC = 1024;
constexpr int NPROMPT = 8192, NSAMP = 512, NMETA = 16;
constexpr int MR = NPROMPT + NSAMP;
constexpr int MT = MR + NMETA;
constexpr int MPAD = 8960;
constexpr float EPS = 1e-6f;

constexpr size_t O_Y = 0;
constexpr size_t O_NCP = (size_t)MR * D;
constexpr size_t O_NPP = O_NCP + 30 * CC;
constexpr size_t O_NCS = O_NPP + 15 * CC;
constexpr size_t O_NPS = O_NCS + 32 * 30 * CC;

constexpr size_t SZ_W1 = (size_t)2 * DFF * D * 2, SZ_W2 = (size_t)D * DFF * 2;
constexpr size_t WS_W1A = 0;
constexpr size_t WS_W2A = WS_W1A + SZ_W1;
constexpr size_t WS_WIN = WS_W2A + SZ_W2;
constexpr size_t WS_WOUT = WS_WIN + (size_t)3072 * D * 2;
constexpr size_t WS_WP = WS_WOUT + (size_t)D * D * 2;
constexpr size_t WS_W1B = WS_WP + (size_t)4 * 256 * 256 * 2;
constexpr size_t WS_W2B = WS_W1B + SZ_W1;
constexpr size_t WS_XN = WS_W2B + SZ_W2;
constexpr size_t WS_ACT = WS_XN + (size_t)MPAD * D * 2;
constexpr size_t WS_UC = WS_ACT;
constexpr size_t WS_UP = WS_UC + (size_t)MPAD * CC * 4;
constexpr size_t WS_PP = WS_UP + (size_t)MPAD * CC * 4;
constexpr size_t WS_H1 = WS_ACT + (size_t)MPAD * DFF * 2;
constexpr size_t WS_CTL = WS_H1 + (size_t)MPAD * D * 4;
constexpr size_t CTL_BYTES = 16384;
constexpr size_t WS_END = WS_CTL + CTL_BYTES;
static_assert(WS_PP + (size_t)MR * CC * 2 <= WS_H1, "overlay");

constexpr int LDS_BYTES = 147456;
constexpr int LDSCTL_OFF = 135168;

struct Args {
    const float* in[22];
    float* out;
    unsigned char* ws;
    int ph_lo, ph_hi;
};

__device__ __forceinline__ unsigned cvt_pk_bf16(float lo, float hi) { unsigned r; asm volatile("v_cvt_pk_bf16_f32 %0, %1, %2" : "=v"(r) : "v"(lo), "v"(hi)); return r; }
__device__ __forceinline__ float wave_sum(float v) {
#pragma unroll
    for (int o = 1; o < 64; o <<= 1) v += __shfl_xor(v, o);
    return v;
}
__device__ __forceinline__ float sigmoidf_fast(float x) { return __builtin_amdgcn_rcpf(1.0f + __builtin_amdgcn_exp2f(-1.44269504089f * x)); }

__device__ __forceinline__ const float* xrow(const float* xp, const float* xs, const float* meta, int r) {
    if (r < NPROMPT) return xp + (size_t)r * D;
    if (r < MR) return xs + (size_t)(r - NPROMPT) * D;
    if (r < MT) return meta + (size_t)(r - MR) * D;
    return nullptr;
}

namespace pg8 {
constexpr int BM = 256, BK = 64, HALF = 128, HTB = HALF * BK * 2, STAGE_BYTES = 8 * HTB, NXCD = 8, WGM = 8;
__host__ __device__ __forceinline__ int lds_byte(int r, int c) { const int st = (r >> 4) * 2 + (c >> 5), rr = r & 15, cc = c & 31, ob = rr * 64 + cc * 2; return st * 1024 + (ob ^ (((ob >> 9) & 1) << 5)); }
__host__ __device__ __forceinline__ void stage_rc(int b, int& R, int& C) { const int st = b / 1024, sb = b % 1024, swz = sb ^ (((sb >> 9) & 1) << 5); R = (st >> 1) * 16 + swz / 64; C = (st & 1) * 32 + (swz % 64) / 2; }
__host__ __device__ __forceinline__ int perm32(int rho) { const int n = rho >> 4, i = rho & 15; return 8 * (i >> 2) + 4 * n + (i & 3); }

struct Unit { const char* a; const char* b; int pm, pn, nt; };

struct TileOrder {
    const char* A; const char* Bt; size_t a_pm, a_pn, b_pn; int nM, nN, nwg, G, c, nt;
    __device__ void init(const void* A_, const void* Bt_, size_t a_pm_, size_t a_pn_, size_t b_pn_, int nM_, int nN_, int nt_, int G_, int c_) {
        A = (const char*)A_; Bt = (const char*)Bt_; a_pm = a_pm_; a_pn = a_pn_; b_pn = b_pn_; nM = nM_; nN = nN_; nwg = nM * nN; nt = nt_; G = G_; c = c_; }
    __device__ bool next(int i, Unit& u) const {
        const long L = (long)i * G + c; if (L >= nwg) return false;
        int wgid = (int)L; { const int q = nwg / NXCD, r = nwg % NXCD, xcd = wgid % NXCD, off = wgid / NXCD; wgid = (xcd < r ? xcd * (q + 1) : r * (q + 1) + (xcd - r) * q) + off; }
        const int nig = WGM * nN, gid = wgid / nig, fm = gid * WGM, gsz = (nM - fm) < WGM ? (nM - fm) : WGM;
        u.pm = fm + ((wgid % nig) % gsz); u.pn = (wgid % nig) / gsz; u.nt = nt;
        u.a = A + (size_t)u.pm * a_pm + (size_t)u.pn * a_pn; u.b = Bt + (size_t)u.pn * b_pn; return true;
    }
};

struct SplitOrder {
    const char* A; const char* Bt; size_t a_pm, b_pn; int nt, c;
    __device__ bool next(int i, Unit& u) const {
        if (i > 0) return false;
        const int xcd = c & 7, idx = c >> 3; u.pm = 4 * xcd + (idx & 3); u.pn = idx >> 2; u.nt = nt;
        u.a = A + (size_t)u.pm * a_pm; u.b = Bt + (size_t)u.pn * b_pn; return true;
    }
};
struct TailOrder {
    const char* A; const char* Bt; size_t a_pm, b_pn; int npairs, nu, nch, c;
    __device__ bool next(int i, Unit& u) const {
        if (i > 0) return false;
        const int L = (c & 7) * 32 + (c >> 3); if (L >= nu * nch) return false;
        const int t = L % nu, ch = L / nu, base = npairs / nch, rem = npairs % nch;
        const int start = ch * base + (ch < rem ? ch : rem), np = base + (ch < rem ? 1 : 0);
        u.pm = t; u.pn = ch; u.nt = 2 * np;
        u.a = A + (size_t)(32 + (t >> 3)) * a_pm + (size_t)start * 256; u.b = Bt + (size_t)(t & 7) * b_pn + (size_t)start * 256; return true;
    }
};

template <class Epi, class Sched, bool ALIGN_EPI, bool PERM>
__device__ __forceinline__ void gemm_phase(LAS unsigned char* lds, const int lda, const int ldb, const Sched& S, const Epi& E) {
    const int tid = threadIdx.x, wid = __builtin_amdgcn_readfirstlane(tid >> 6), lane = tid & 63, wr = wid >> 2, wc = wid & 3, fr = lane & 15, fq = lane >> 4;
    unsigned voffA[2], voffB[2];
#pragma unroll
    for (int i = 0; i < 2; ++i) { int R, C; stage_rc(tid * 16 + i * 8192, R, C); const int Rb = PERM ? ((R & ~31) + perm32(R & 31)) : R;
        voffA[i] = (unsigned)(R * lda + C) * 2u; voffB[i] = (unsigned)(Rb * ldb + C) * 2u; }
    const size_t kstep = (size_t)(BK * 2);
    const size_t hstepA = (size_t)HALF * lda * 2, hstepB = (size_t)HALF * ldb * 2;
    const unsigned ldsw = (unsigned)wid * 1024u;
    const int aoff = lds_byte(wr * 64 + fr, fq * 8), boff = lds_byte(wc * 32 + fr, fq * 8);
#define PG8_SA(b, h) (((b) * 2 + (h)) * HTB)
#define PG8_SB(b, h) ((4 + (b) * 2 + (h)) * HTB)
#define PG8_STAGE(bufoff, gbase, voff) do { _Pragma("unroll") for (int _i = 0; _i < 2; ++_i) \
        __builtin_amdgcn_global_load_lds((const unsigned*)((const char*)(gbase) + (voff)[_i]), (LAS unsigned*)(lds + (bufoff) + ldsw + _i * 8192), 16, 0, 0); } while (0)
#define PG8_LDA(dst, b, h) do { _Pragma("unroll") for (int m = 0; m < 4; ++m) _Pragma("unroll") for (int k = 0; k < 2; ++k) dst[m][k] = *(const LAS bf16x8*)(lds + PG8_SA(b, h) + aoff + m * 2048 + k * 1024); } while (0)
#define PG8_LDB(dst, b, h) do { _Pragma("unroll") for (int n = 0; n < 2; ++n) _Pragma("unroll") for (int k = 0; k < 2; ++k) dst[n][k] = *(const LAS bf16x8*)(lds + PG8_SB(b, h) + boff + n * 2048 + k * 1024); } while (0)
#define PG8_MMA(ai, bj, At, Bt) do { __builtin_amdgcn_s_setprio(1); _Pragma("unroll") for (int m = 0; m < 4; ++m) _Pragma("unroll") for (int n = 0; n < 2; ++n) _Pragma("unroll") for (int k = 0; k < 2; ++k) \
        acc[ai][bj][m][n] = __builtin_amdgcn_mfma_f32_16x16x32_bf16(Bt[n][k], At[m][k], acc[ai][bj][m][n], 0, 0, 0); __builtin_amdgcn_s_setprio(0); } while (0)
#define PG8_WAIT_V(n) asm volatile("s_waitcnt vmcnt(" #n ")" ::: "memory")
#define PG8_WAIT_L(n) asm volatile("s_waitcnt lgkmcnt(" #n ")" ::: "memory")
#define PG8_BAR __builtin_amdgcn_s_barrier()
#define PG8_SCHED __builtin_amdgcn_sched_barrier(0)
    Unit cur, nxt; int ui = 0;
    if (!S.next(0, cur)) return;
    f32x4 acc[2][2][4][2];
#pragma unroll
    for (int a = 0; a < 2; ++a)
#pragma unroll
        for (int b = 0; b < 2; ++b)
#pragma unroll
            for (int m = 0; m < 4; ++m)
#pragma unroll
                for (int n = 0; n < 2; ++n) acc[a][b][m][n] = (f32x4){0.f, 0.f, 0.f, 0.f};
    bf16x8 At[4][2], B0[2][2], B1[2][2];
    const char* cA = cur.a; const char* cB = cur.b;
    PG8_STAGE(PG8_SB(0, 0), cB, voffB); PG8_STAGE(PG8_SB(0, 1), cB + hstepB, voffB); PG8_STAGE(PG8_SA(0, 0), cA, voffA); PG8_STAGE(PG8_SA(0, 1), cA + hstepA, voffA);
    if (wr == 1) PG8_BAR;
    PG8_WAIT_V(2); PG8_BAR;
    PG8_STAGE(PG8_SB(1, 0), cB + kstep, voffB); PG8_STAGE(PG8_SA(1, 0), cA + kstep, voffA); PG8_STAGE(PG8_SB(1, 1), cB + hstepB + kstep, voffB);
    PG8_WAIT_V(6); PG8_BAR;
    for (;;) {
        const bool has_next = S.next(ui + 1, nxt);
        const char* nA = has_next ? nxt.a : cA; const char* nB = has_next ? nxt.b : cB;
        const int nt = cur.nt;
        for (int t = 0; t < nt; t += 2) {
            const bool last = (t == nt - 2);
            const char* a1 = cA + (size_t)(t + 1) * kstep;
            const char* a2 = last ? nA : cA + (size_t)(t + 2) * kstep; const char* b2 = last ? nB : cB + (size_t)(t + 2) * kstep;
            const char* a3 = a2 + kstep; const char* b3 = b2 + kstep;
            PG8_LDB(B0, 0, 0); PG8_LDB(B1, 0, 1); PG8_SCHED; PG8_LDA(At, 0, 0); PG8_STAGE(PG8_SA(1, 1), a1 + hstepA, voffA);
            PG8_WAIT_V(8); PG8_WAIT_L(0); PG8_BAR; PG8_MMA(0, 0, At, B0); PG8_MMA(0, 1, At, B1); PG8_BAR; PG8_SCHED;
            PG8_LDA(At, 0, 1); PG8_STAGE(PG8_SB(0, 0), b2, voffB); PG8_STAGE(PG8_SB(0, 1), b2 + hstepB, voffB); PG8_STAGE(PG8_SA(0, 0), a2, voffA);
            PG8_WAIT_V(8); PG8_WAIT_L(0); PG8_BAR; PG8_MMA(1, 0, At, B0); PG8_MMA(1, 1, At, B1); PG8_BAR; PG8_SCHED;
            PG8_LDB(B0, 1, 0); PG8_LDB(B1, 1, 1); PG8_SCHED; PG8_LDA(At, 1, 0); PG8_STAGE(PG8_SA(0, 1), a2 + hstepA, voffA);
            PG8_WAIT_V(8); PG8_WAIT_L(0); PG8_BAR; PG8_MMA(0, 0, At, B0); PG8_MMA(0, 1, At, B1); PG8_BAR; PG8_SCHED;
            PG8_LDA(At, 1, 1); PG8_STAGE(PG8_SB(1, 0), b3, voffB); PG8_STAGE(PG8_SB(1, 1), b3 + hstepB, voffB); PG8_STAGE(PG8_SA(1, 0), a3, voffA);
            PG8_WAIT_V(8); PG8_WAIT_L(0); PG8_BAR; PG8_MMA(1, 0, At, B0); PG8_MMA(1, 1, At, B1); PG8_BAR; PG8_SCHED;
        }
        if constexpr (ALIGN_EPI) { if (wr == 0) PG8_BAR; }
        E(acc, cur, wr, wc, fr, fq);
        if (!has_next) break;
#pragma unroll
        for (int a = 0; a < 2; ++a)
#pragma unroll
            for (int b = 0; b < 2; ++b)
#pragma unroll
                for (int m = 0; m < 4; ++m)
#pragma unroll
                    for (int n = 0; n < 2; ++n) acc[a][b][m][n] = (f32x4){0.f, 0.f, 0.f, 0.f};
        cur = nxt; cA = nA; cB = nB; ++ui;
        if constexpr (ALIGN_EPI) { if (wr == 1) PG8_BAR; }
    }
    PG8_WAIT_V(0);
    if constexpr (!ALIGN_EPI) { if (wr == 0) PG8_BAR; }
    PG8_BAR;
#undef PG8_SA
#undef PG8_SB
#undef PG8_STAGE
#undef PG8_LDA
#undef PG8_LDB
#undef PG8_MMA
#undef PG8_WAIT_V
#undef PG8_WAIT_L
#undef PG8_BAR
#undef PG8_SCHED
}
}

struct EpiSwiglu {
    bf16_t* O;
    __device__ __forceinline__ void operator()(const f32x4 (&acc)[2][2][4][2], const pg8::Unit& u, int wr, int wc, int fr, int fq) const {
        const int row0 = u.pm * 256 + wr * 64 + fr, col0 = u.pn * 128 + wc * 32 + 8 * fq;
#pragma unroll
        for (int ai = 0; ai < 2; ++ai)
#pragma unroll
            for (int m = 0; m < 4; ++m) {
                bf16_t* rowp = O + (size_t)(row0 + ai * 128 + m * 16) * DFF + col0;
                float o[8];
#pragma unroll
                for (int n = 0; n < 2; ++n)
#pragma unroll
                    for (int j = 0; j < 4; ++j) { const float g = acc[ai][0][m][n][j], up = acc[ai][1][m][n][j]; o[4 * n + j] = g * sigmoidf_fast(g) * up; }
                u32x4 w; w.x = cvt_pk_bf16(o[0], o[1]); w.y = cvt_pk_bf16(o[2], o[3]); w.z = cvt_pk_bf16(o[4], o[5]); w.w = cvt_pk_bf16(o[6], o[7]);
                *(u32x4*)rowp = w;
            }
    }
};
template <bool XMODE> struct EpiResid {
    const float* base; const float* xs; const float* meta; float* out; float scale;
    __device__ __forceinline__ void operator()(const f32x4 (&acc)[2][2][4][2], const pg8::Unit& u, int wr, int wc, int fr, int fq) const {
        const int row0 = u.pm * 256 + wr * 64 + fr, col0 = u.pn * 256 + wc * 32 + 4 * fq;
#pragma unroll
        for (int ai = 0; ai < 2; ++ai)
#pragma unroll
            for (int m = 0; m < 4; ++m) {
                const int r = row0 + ai * 128 + m * 16;
                const float* bp = XMODE ? xrow(base, xs, meta, r) : base + (size_t)r * D;
                float* op = out + (size_t)r * D + col0;
#pragma unroll
                for (int bj = 0; bj < 2; ++bj)
#pragma unroll
                    for (int n = 0; n < 2; ++n) {
                        f32x4 bv = (f32x4){0.f, 0.f, 0.f, 0.f};
                        if (!XMODE || bp) bv = *(const f32x4*)(bp + col0 + bj * 128 + n * 16);
                        *(f32x4*)(op + bj * 128 + n * 16) = bv + acc[ai][bj][m][n] * scale;
                    }
            }
    }
};
struct EpiGluPool {
    float* UC; float* UP;
    __device__ __forceinline__ void operator()(const f32x4 (&acc)[2][2][4][2], const pg8::Unit& u, int wr, int wc, int fr, int fq) const {
        const int row0 = u.pm * 256 + wr * 64 + fr;
        if (u.pn < 8) {
            const int col0 = u.pn * 128 + wc * 32 + 4 * fq;
#pragma unroll
            for (int ai = 0; ai < 2; ++ai)
#pragma unroll
                for (int m = 0; m < 4; ++m) {
                    float* op = UC + (size_t)(row0 + ai * 128 + m * 16) * CC + col0;
#pragma unroll
                    for (int n = 0; n < 2; ++n) {
                        const f32x4 a = acc[ai][0][m][n], g = acc[ai][1][m][n]; f32x4 o;
#pragma unroll
                        for (int j = 0; j < 4; ++j) o[j] = a[j] * sigmoidf_fast(g[j]);
                        *(f32x4*)(op + n * 16) = o;
                    }
                }
        } else {
            const int col0 = (u.pn - 8) * 256 + wc * 32 + 4 * fq;
#pragma unroll
            for (int ai = 0; ai < 2; ++ai)
#pragma unroll
                for (int m = 0; m < 4; ++m) {
                    float* op = UP + (size_t)(row0 + ai * 128 + m * 16) * CC + col0;
#pragma unroll
                    for (int bj = 0; bj < 2; ++bj)
#pragma unroll
                        for (int n = 0; n < 2; ++n) *(f32x4*)(op + bj * 128 + n * 16) = acc[ai][bj][m][n];
                }
        }
    }
};
struct EpiPool {
    bf16_t* MIX; const float* scale;
    __device__ __forceinline__ void operator()(const f32x4 (&acc)[2][2][4][2], const pg8::Unit& u, int wr, int wc, int fr, int fq) const {
        const int row0 = u.pm * 256 + wr * 64 + fr, c0 = u.pn * 256 + wc * 32 + 8 * fq;
        f32x4 sv[2][2];
#pragma unroll
        for (int bj = 0; bj < 2; ++bj)
#pragma unroll
            for (int n = 0; n < 2; ++n) sv[bj][n] = *(const f32x4*)(scale + c0 + bj * 128 + 4 * n);
#pragma unroll
        for (int ai = 0; ai < 2; ++ai)
#pragma unroll
            for (int m = 0; m < 4; ++m) {
                bf16_t* rowp = MIX + (size_t)(row0 + ai * 128 + m * 16) * 2048 + 1024 + c0;
#pragma unroll
                for (int bj = 0; bj < 2; ++bj) {
                    const f32x4 v0 = acc[ai][bj][m][0] * sv[bj][0], v1 = acc[ai][bj][m][1] * sv[bj][1];
                    u32x4 w; w.x = cvt_pk_bf16(v0[0], v0[1]); w.y = cvt_pk_bf16(v0[2], v0[3]); w.z = cvt_pk_bf16(v1[0], v1[1]); w.w = cvt_pk_bf16(v1[2], v1[3]);
                    *(u32x4*)(rowp + bj * 128) = w;
                }
            }
    }
};

struct EpiPartial {
    float* part; int nch;
    __device__ __forceinline__ void operator()(const f32x4 (&acc)[2][2][4][2], const pg8::Unit& u, int wr, int wc, int fr, int fq) const {
        float* tp = part + ((size_t)(u.pm * nch + u.pn) << 16) + (size_t)(wr * 64 + fr) * 256 + wc * 32 + 4 * fq;
#pragma unroll
        for (int ai = 0; ai < 2; ++ai)
#pragma unroll
            for (int m = 0; m < 4; ++m)
#pragma unroll
                for (int bj = 0; bj < 2; ++bj)
#pragma unroll
                    for (int n = 0; n < 2; ++n) *(f32x4*)(tp + (ai * 128 + m * 16) * 256 + bj * 128 + n * 16) = acc[ai][bj][m][n];
    }
};
template <bool FINAL> __device__ __forceinline__ void heavy_row(const float* base_row, float scale, const float* part, int nch, int trow, int lr, const float* g, float* hout, bf16_t* xn, int lane) {
    f32x4 v[8];
#pragma unroll
    for (int j = 0; j < 8; ++j) v[j] = (f32x4){0.f, 0.f, 0.f, 0.f};
    const float* pp = part + (size_t)lr * 256 + 4 * lane;
    for (int c = 0; c < nch; ++c) {
#pragma unroll
        for (int j = 0; j < 8; ++j) v[j] += *(const f32x4*)(pp + ((size_t)((trow * 8 + j) * nch + c) << 16));
    }
    float s = 0.f;
#pragma unroll
    for (int j = 0; j < 8; ++j) {
        f32x4 b = (f32x4){0.f, 0.f, 0.f, 0.f};
        if (base_row) b = *((const f32x4*)base_row + lane + 64 * j);
        v[j] = b + v[j] * scale;
        s += (v[j].x * v[j].x + v[j].y * v[j].y) + (v[j].z * v[j].z + v[j].w * v[j].w);
    }
    const float rs = rsqrtf(wave_sum(s) * (1.f / D) + EPS);
    const f32x4* gr = (const f32x4*)g + lane;
#pragma unroll
    for (int j = 0; j < 8; ++j) {
        const f32x4 gv = gr[64 * j]; const f32x4 y = v[j] * rs * gv;
        if (FINAL) { *((f32x4*)hout + lane + 64 * j) = y; }
        else { *((f32x4*)hout + lane + 64 * j) = v[j]; *((u32x2*)xn + lane + 64 * j) = (u32x2){cvt_pk_bf16(y.x, y.y), cvt_pk_bf16(y.z, y.w)}; }
    }
}

struct CvtItem { const float* s; bf16_t* d; size_t ldn, ldk; };
__device__ __forceinline__ int cvt_row0(int mode, int n0) {
    if (mode == 0) return n0;
    if (mode == 1) return 256 * (n0 >> 7) + (n0 & 127);
    if (mode == 2) return 256 * (n0 >> 7) + 128 + (n0 & 127);
    return n0 < 1024 ? 256 * (n0 >> 7) + (n0 & 127) : (n0 < 2048 ? 256 * ((n0 - 1024) >> 7) + 128 + ((n0 - 1024) & 127) : n0);
}
template <int N, int K> __device__ __forceinline__ CvtItem cvt_make(const float* src, bf16_t* dst, int item, int mode, int lane) {
    constexpr int NB = N / 64;
    const int kb = item / NB, nb = item - kb * NB, n0 = nb * 64, k0 = kb * 64;
    CvtItem c; c.s = src + (size_t)k0 * N + n0 + lane; c.d = dst + (size_t)cvt_row0(mode, n0) * K + k0; c.ldn = N; c.ldk = K; return c;
}
__device__ __forceinline__ void cvt_load64(float (&v)[64], const float* s, size_t ldn) {
#pragma unroll
    for (int i = 0; i < 64; ++i) v[i] = s[(size_t)i * ldn];
}
__device__ __forceinline__ void cvt_xpose_store(const float (&v)[64], bf16_t* d, size_t ldk, LAS float* scr, int lane) {
#pragma unroll
    for (int i = 0; i < 64; ++i) scr[i * 65 + lane] = v[i];
    asm volatile("s_waitcnt lgkmcnt(0)" ::: "memory");
    const int c = lane & 7, nl = lane >> 3;
#pragma unroll
    for (int j = 0; j < 8; ++j) {
        const LAS float* q = scr + (8 * c) * 65 + nl + 8 * j;
        u32x4 w; w.x = cvt_pk_bf16(q[0], q[65]); w.y = cvt_pk_bf16(q[2 * 65], q[3 * 65]); w.z = cvt_pk_bf16(q[4 * 65], q[5 * 65]); w.w = cvt_pk_bf16(q[6 * 65], q[7 * 65]);
        *(u32x4*)(d + (size_t)(nl + 8 * j) * ldk + 8 * c) = w;
    }
    asm volatile("s_waitcnt lgkmcnt(0)" ::: "memory");
}
template <class Get> __device__ __forceinline__ void cvt_stream(int first, int stride, int n, LAS float* scr, int lane, const Get& get) {
    if (first >= n) return;
    float va[64], vb[64];
    int it = first; CvtItem cur = get(it);
    cvt_load64(va, cur.s, cur.ldn);
    for (;;) {
        int nx = it + stride; bool has = nx < n; CvtItem nd = cur;
        if (has) { nd = get(nx); cvt_load64(vb, nd.s, nd.ldn); }
        cvt_xpose_store(va, cur.d, cur.ldk, scr, lane);
        if (!has) break;
        cur = nd; it = nx;
        nx = it + stride; has = nx < n;
        if (has) { nd = get(nx); cvt_load64(va, nd.s, nd.ldn); }
        cvt_xpose_store(vb, cur.d, cur.ldk, scr, lane);
        if (!has) break;
        cur = nd; it = nx;
    }
}

__device__ __forceinline__ void norm_row_bf16(const float* src, const float* g, bf16_t* dst, int lane) {
    u32x2* o8 = (u32x2*)dst + lane;
    if (!src) {
#pragma unroll
        for (int j = 0; j < 8; ++j) o8[64 * j] = (u32x2){0u, 0u};
        return;
    }
    const f32x4* xr = (const f32x4*)src + lane; const f32x4* gr = (const f32x4*)g + lane;
    f32x4 v[8]; float s = 0.f;
#pragma unroll
    for (int j = 0; j < 8; ++j) { v[j] = xr[64 * j]; s += (v[j].x * v[j].x + v[j].y * v[j].y) + (v[j].z * v[j].z + v[j].w * v[j].w); }
    const float rs = rsqrtf(wave_sum(s) * (1.f / D) + EPS);
#pragma unroll
    for (int j = 0; j < 8; ++j) { const f32x4 gv = gr[64 * j]; const f32x4 y = v[j] * rs * gv; o8[64 * j] = (u32x2){cvt_pk_bf16(y.x, y.y), cvt_pk_bf16(y.z, y.w)}; }
}
__device__ __forceinline__ void norm_row_f32_inplace(float* row, const float* g, int lane) {
    f32x4* xr = (f32x4*)row + lane; const f32x4* gr = (const f32x4*)g + lane;
    f32x4 v[8]; float s = 0.f;
#pragma unroll
    for (int j = 0; j < 8; ++j) { v[j] = xr[64 * j]; s += (v[j].x * v[j].x + v[j].y * v[j].y) + (v[j].z * v[j].z + v[j].w * v[j].w); }
    const float rs = rsqrtf(wave_sum(s) * (1.f / D) + EPS);
#pragma unroll
    for (int j = 0; j < 8; ++j) { const f32x4 gv = gr[64 * j]; xr[64 * j] = v[j] * rs * gv; }
}

__device__ __forceinline__ const float* conv_src_row(int it, int e, const float* UC, const float* sc, bool& ok) {
    const int p = 16 * it - 14 + e, b = it - 512;
    const size_t rp = (size_t)(p < 16 ? (p < 0 ? 0 : MR + p) : p - 16);
    const float* a0 = UC + rp * CC;
    const float* a1 = e < 30 ? sc + (size_t)(b * 30 + e) * CC : UC + (size_t)(NPROMPT + 16 * b + e - 30) * CC;
    ok = (it >= 512) || (p >= 0);
    return it < 512 ? a0 : a1;
}
__device__ __forceinline__ const float* pool_src_row(int it, int e, const float* UP, const float* sp) {
    const int p = 16 * it + 1 + e, b = it - 512;
    const float* a0 = UP + (size_t)(p < 16 ? MR + p : p - 16) * CC;
    const float* a1 = e < 15 ? sp + (size_t)(b * 15 + e) * CC : UP + (size_t)(NPROMPT + 16 * b + e - 15) * CC;
    return it < 512 ? a0 : a1;
}
__device__ __forceinline__ void mixer_item(int it, const float* UC, const float* UP, const float* sc, const float* sp, const float* conv_w, const float* conv_b, const float* conv_norm,
                                           bf16_t* MIX, bf16_t* PP, float* out, const LAS float* wl, LAS float* red, int tid) {
    const int lane = tid & 63, wave = tid >> 6, ch = 2 * tid;
    const bool wstate = (it >= 511);
    float* ncv = out + (it == 511 ? O_NCP : O_NCS + (size_t)(it - 512) * 30 * CC);
    float* npl = out + (it == 511 ? O_NPP : O_NPS + (size_t)(it - 512) * 15 * CC);
    f32x2 ext[46];
#pragma unroll
    for (int e = 0; e < 46; ++e) {
        bool ok; const float* rp = conv_src_row(it, e, UC, sc, ok);
        const f32x2 v = *(const f32x2*)(rp + ch);
        ext[e] = ok ? v : (f32x2){0.f, 0.f};
    }
    const f32x2 bias = *(const f32x2*)(conv_b + ch);
    if (wstate) {
#pragma unroll
        for (int i = 0; i < 30; ++i) *(f32x2*)(ncv + (size_t)i * CC + ch) = ext[16 + i];
    }
    f32x2 y[16];
#pragma unroll
    for (int t = 0; t < 16; ++t) y[t] = bias;
#pragma unroll
    for (int j = 0; j < 31; ++j) {
        const f32x2 wj = *(const LAS f32x2*)(wl + j * CC + ch);
#pragma unroll
        for (int t = 0; t < 16; ++t) y[t] += wj * ext[t + j];
    }
    float ss[16];
#pragma unroll
    for (int t = 0; t < 16; ++t) ss[t] = wave_sum(y[t].x * y[t].x + y[t].y * y[t].y);
    __syncthreads();
    if (lane == 0) {
#pragma unroll
        for (int t = 0; t < 16; ++t) red[wave * 16 + t] = ss[t];
    }
    __syncthreads();
    const f32x2 gcn = *(const f32x2*)(conv_norm + ch);
#pragma unroll
    for (int t = 0; t < 16; ++t) {
        float s = 0.f;
#pragma unroll
        for (int q = 0; q < 8; ++q) s += red[q * 16 + t];
        const float rs = rsqrtf(s * (1.f / CC) + EPS);
        const float a = y[t].x * rs * gcn.x, b = y[t].y * rs * gcn.y;
        const float ca = a * sigmoidf_fast(a), cb = b * sigmoidf_fast(b);
        *(unsigned*)(MIX + (size_t)(16 * it + t) * 2048 + ch) = cvt_pk_bf16(ca, cb);
    }
    const int wwin = 2 << (tid >> 7);
    const float inv = 1.0f / (float)wwin;
    f32x2 x[31];
#pragma unroll
    for (int e = 0; e < 31; ++e) { const float* rp = pool_src_row(it, e, UP, sp); x[e] = *(const f32x2*)(rp + ch); }
    if (wstate) {
#pragma unroll
        for (int i = 0; i < 15; ++i) *(f32x2*)(npl + (size_t)i * CC + ch) = x[16 + i];
    }
#pragma unroll
    for (int t = 0; t < 16; ++t) {
        f32x2 s = (f32x2){0.f, 0.f};
#pragma unroll
        for (int k = 0; k < 16; ++k) { const f32x2 xv = x[15 + t - k]; s += (k < wwin) ? xv : (f32x2){0.f, 0.f}; }
        const f32x2 p = s * inv - x[15 + t];
        *(unsigned*)(PP + (size_t)(16 * it + t) * CC + ch) = cvt_pk_bf16(p.x, p.y);
    }
}

#define XB_TMO      128
#define XB_XCNT(j)  (256  + 64 * (j))
#define XB_XSUB(j)  (1280 + 64 * (j))
#define XB_XGEN(j)  (2304 + 64 * (j))
#define XB_TOP      3328
#define XB_TOPGEN   3392
#define XCD_BAR_WORDS 3456
#define XB_SPIN_CAP (1u << 18)

__device__ __forceinline__ unsigned xb_ld(unsigned* p)              { return __hip_atomic_load(p, __ATOMIC_RELAXED, __HIP_MEMORY_SCOPE_AGENT); }
__device__ __forceinline__ unsigned xb_add(unsigned* p, unsigned v) { return __hip_atomic_fetch_add(p, v, __ATOMIC_RELAXED, __HIP_MEMORY_SCOPE_AGENT); }
__device__ __forceinline__ unsigned xb_xcc_id() { return (unsigned)__builtin_amdgcn_s_getreg((3 << 11) | 20) & 0xFu; }
#define XB_SPIN(cond, bar) do { unsigned _sp = 0; while (cond) { __builtin_amdgcn_s_sleep(1); \
    if ((++_sp & 255u) == 0u) { if (xb_ld(&(bar)[XB_TMO])) break; if (_sp > XB_SPIN_CAP) { atomicAdd(&(bar)[XB_TMO], 1u); break; } } } } while (0)

struct XcdBarrier {
    unsigned* bar; unsigned x;
    volatile LAS unsigned* st;
};

__device__ __forceinline__ XcdBarrier xcd_barrier_post(unsigned* bar, volatile LAS unsigned* st) {
    XcdBarrier b; b.bar = bar; b.x = xb_xcc_id(); b.st = st;
    if (threadIdx.x == 0) (void)xb_add(&bar[XB_XCNT(b.x)], 1u);
    return b;
}
__device__ __forceinline__ void xcd_barrier_complete(unsigned* bar, unsigned x, unsigned& nloc, unsigned& nx) {
    const unsigned G = gridDim.x * gridDim.y * gridDim.z;
    unsigned sum, cnt, mine, sp = 0u;
    for (;;) {
        sum = 0u; cnt = 0u; mine = 0u;
#pragma unroll
        for (unsigned j = 0; j < 16; ++j) { const unsigned c = xb_ld(&bar[XB_XCNT(j)]); sum += c; cnt += (c > 0u) ? 1u : 0u; mine = (j == x) ? c : mine; }
        if (sum == G) break;
        __builtin_amdgcn_s_sleep(1);
        if ((++sp & 255u) == 0u) { if (xb_ld(&bar[XB_TMO])) break; if (sp > XB_SPIN_CAP) { atomicAdd(&bar[XB_TMO], 1u); break; } }
    }
    nloc = mine > 0u ? mine : 1u; nx = cnt > 0u ? cnt : 1u;
}

__device__ __forceinline__ void xcd_barrier(const XcdBarrier& b) {
    asm volatile("s_waitcnt vmcnt(0)" ::: "memory");
    __syncthreads();
    if (threadIdx.x == 0) {
        unsigned* bar = b.bar;
        __builtin_amdgcn_s_waitcnt(0);
        unsigned nloc = b.st[0], nx = b.st[1];
        if (nloc == 0u) { xcd_barrier_complete(bar, b.x, nloc, nx); b.st[0] = nloc; b.st[1] = nx; }
        const unsigned old = xb_add(&bar[XB_XSUB(b.x)], 1u);
        const unsigned gen = old / nloc;
        if (old + 1u == (gen + 1u) * nloc) {
            __builtin_amdgcn_fence(__ATOMIC_RELEASE, "agent");
            asm volatile("s_waitcnt vmcnt(0)" ::: "memory");
            const unsigned og = xb_add(&bar[XB_TOP], 1u);
            const unsigned tg = og / nx;
            if (og + 1u == (tg + 1u) * nx) xb_add(&bar[XB_TOPGEN], 1u);
            else XB_SPIN(xb_ld(&bar[XB_TOPGEN]) == tg, bar);
            __builtin_amdgcn_fence(__ATOMIC_ACQUIRE, "agent");
            xb_add(&bar[XB_XGEN(b.x)], 1u);
            asm volatile("s_waitcnt vmcnt(0)" ::: "memory");
        } else {
            XB_SPIN(xb_ld(&bar[XB_XGEN(b.x)]) == gen, bar);
            __builtin_amdgcn_fence(__ATOMIC_ACQUIRE, "agent");
            asm volatile("s_waitcnt vmcnt(0)" ::: "memory");
        }
    }
    __syncthreads();
}

constexpr int N_PHASES = 12;
__global__ void __launch_bounds__(512, 2) mk_fwd(Args args) {
    extern __shared__ __attribute__((aligned(16))) unsigned char lds_raw[];
    LAS unsigned char* lds = (LAS unsigned char*)lds_raw;
    cg::grid_group grid = cg::this_grid();
    const int tid = threadIdx.x, lane = tid & 63, wave = __builtin_amdgcn_readfirstlane(tid >> 6);
    const int G = gridDim.x, bx = blockIdx.x;
    const int gw = bx * 8 + wave, NGW = G * 8;
    unsigned char* ws = args.ws;
    const float* x_prompt = args.in[0]; const float* x_sample = args.in[1]; const float* state_conv = args.in[2]; const float* state_pool = args.in[3]; const float* meta = args.in[4];
    const float* ffn1_norm = args.in[5]; const float* mix_norm = args.in[9]; const float* conv_w = args.in[11]; const float* conv_b = args.in[12]; const float* conv_norm = args.in[13];
    const float* pool_scale = args.in[15]; const float* ffn2_norm = args.in[17]; const float* final_norm = args.in[21];
    bf16_t* W1A = (bf16_t*)(ws + WS_W1A); bf16_t* W2A = (bf16_t*)(ws + WS_W2A); bf16_t* WIN = (bf16_t*)(ws + WS_WIN); bf16_t* WOUT = (bf16_t*)(ws + WS_WOUT); bf16_t* WP = (bf16_t*)(ws + WS_WP);
    bf16_t* W1B = (bf16_t*)(ws + WS_W1B); bf16_t* W2B = (bf16_t*)(ws + WS_W2B);
    bf16_t* XN = (bf16_t*)(ws + WS_XN); bf16_t* MIX = XN; bf16_t* ACT = (bf16_t*)(ws + WS_ACT);
    float* UC = (float*)(ws + WS_UC); float* UP = (float*)(ws + WS_UP); bf16_t* PP = (bf16_t*)(ws + WS_PP);
    float* H1 = (float*)(ws + WS_H1); float* H2 = args.out + O_Y;
    float* PART_A = args.out;
    float* PART_B = (float*)(ws + WS_ACT);
    float* PART_C = H1;
    const int lo = args.ph_lo, hi = args.ph_hi;
    for (int u = tid; u < (LDS_BYTES - LDSCTL_OFF) / 4; u += 512) ((LAS unsigned*)(lds + LDSCTL_OFF))[u] = 0u;
    __syncthreads();
    XcdBarrier bar = xcd_barrier_post((unsigned*)(ws + WS_CTL), (volatile LAS unsigned*)(lds + LDSCTL_OFF + 64));
    if (lo == -12345) grid.sync();
#define IN(k) (lo <= (k) && (k) < hi)
#define REP(k) for (int rep_ = 0; rep_ < 1 + ((PROBE_MASK >> (k)) & 1); ++rep_)
#define SEAM(k) do { if (IN(k) && IN((k) + 1)) xcd_barrier(bar); } while (0)

    for (int i_ = 0; i_ < PROBE_SYNCS; ++i_) xcd_barrier(bar);
    constexpr int I_F = 32 * 88, I_IN = 32 * 48, I_OUT = 32 * 32, I_P = 16;
    constexpr int G_GEMM1 = 224;
    if (IN(0)) REP(0) {
        cvt_stream(gw, NGW, 2 * I_F, (LAS float*)lds + wave * (64 * 65), lane, [&](int it) {
            return it < I_F ? cvt_make<DFF, D>(args.in[6], W1A, it, 1, lane) : cvt_make<DFF, D>(args.in[7], W1A, it - I_F, 2, lane); });
        for (int m = gw; m < MPAD; m += NGW) norm_row_bf16(xrow(x_prompt, x_sample, meta, m), ffn1_norm, XN + (size_t)m * D, lane);
    }
    SEAM(0);
    if (IN(1)) REP(1) {
        if (bx < G_GEMM1 || G <= G_GEMM1) {
            pg8::TileOrder S; S.init(XN, W1A, (size_t)256 * D * 2, 0, (size_t)256 * D * 2, MPAD / 256, 2 * DFF / 256, D / 64, G > G_GEMM1 ? G_GEMM1 : G, bx);
            EpiSwiglu E{ACT};
            pg8::gemm_phase<EpiSwiglu, pg8::TileOrder, true, true>(lds, D, D, S, E);
        }
        if (bx >= G_GEMM1 || G <= G_GEMM1) {
            constexpr int NITEMS = 4 * I_F + I_IN + I_OUT + 4 * I_P;
            const int cw = (G > G_GEMM1 ? (bx - G_GEMM1) : bx) * 8 + wave, ncw = (G > G_GEMM1 ? (G - G_GEMM1) : G) * 8;
            cvt_stream(cw, ncw, NITEMS, (LAS float*)lds + wave * (64 * 65), lane, [&](int it) {
                int r = it;
                if (r < I_F) return cvt_make<D, DFF>(args.in[8], W2A, r, 0, lane);
                r -= I_F;
                if (r < I_IN) return cvt_make<3072, D>(args.in[10], WIN, r, 3, lane);
                r -= I_IN;
                if (r < I_OUT) return cvt_make<D, D>(args.in[16], WOUT, r, 0, lane);
                r -= I_OUT;
                if (r < 4 * I_P) { const int g = r / I_P; return cvt_make<256, 256>(args.in[14] + (size_t)g * 65536, WP + (size_t)g * 65536, r % I_P, 0, lane); }
                r -= 4 * I_P;
                if (r < I_F) return cvt_make<DFF, D>(args.in[18], W1B, r, 1, lane);
                r -= I_F;
                if (r < I_F) return cvt_make<DFF, D>(args.in[19], W1B, r, 2, lane);
                r -= I_F;
                return cvt_make<D, DFF>(args.in[20], W2B, r, 0, lane); });
        }
    }
    SEAM(1);
    if (IN(2)) REP(2) {
        {   pg8::SplitOrder S{(const char*)ACT, (const char*)W2A, (size_t)256 * DFF * 2, (size_t)256 * DFF * 2, DFF / 64, bx};
            EpiResid<true> E{x_prompt, x_sample, meta, H1, 0.5f};
            pg8::gemm_phase<EpiResid<true>, pg8::SplitOrder, false, false>(lds, DFF, DFF, S, E); }
        {   pg8::TailOrder S{(const char*)ACT, (const char*)W2A, (size_t)256 * DFF * 2, (size_t)256 * DFF * 2, DFF / 128, 24, 10, bx};
            EpiPartial E{PART_A, 10};
            pg8::gemm_phase<EpiPartial, pg8::TailOrder, false, false>(lds, DFF, DFF, S, E); }
    }
    SEAM(2);
    if (IN(3)) REP(3) {
        for (int m = gw; m < NPROMPT; m += NGW) norm_row_bf16(H1 + (size_t)m * D, mix_norm, XN + (size_t)m * D, lane);
        for (int h = wave * G + bx; h < MPAD - NPROMPT; h += 8 * G) {
            const int m = NPROMPT + h;
            if (m < MT) heavy_row<false>(xrow(x_prompt, x_sample, meta, m), 0.5f, PART_A, 10, h >> 8, h & 255, mix_norm, H1 + (size_t)m * D, XN + (size_t)m * D, lane);
            else norm_row_bf16(nullptr, mix_norm, XN + (size_t)m * D, lane);
        }
    }
    SEAM(3);
    if (IN(4)) REP(4) {
        pg8::TileOrder S; S.init(XN, WIN, (size_t)256 * D * 2, 0, (size_t)256 * D * 2, MPAD / 256, 3072 / 256, D / 64, G, bx);
        EpiGluPool E{UC, UP};
        pg8::gemm_phase<EpiGluPool, pg8::TileOrder, true, false>(lds, D, D, S, E);
    }
    SEAM(4);
    if (IN(5)) REP(5) {
        LAS float* wl = (LAS float*)lds;
        for (int i = tid; i < 31 * CC / 4; i += 512) *((LAS f32x4*)wl + i) = *((const f32x4*)conv_w + i);
        __syncthreads();
        for (int it = bx; it < 544; it += G)
            mixer_item(it, UC, UP, state_conv, state_pool, conv_w, conv_b, conv_norm, MIX, PP, args.out, wl, wl + 31 * CC, tid);
        __syncthreads();
    }
    SEAM(5);
    if (IN(6)) REP(6) {
        pg8::TileOrder S; S.init(PP, WP, (size_t)256 * CC * 2, (size_t)256 * 2, (size_t)256 * 256 * 2, MR / 256, 4, 256 / 64, G, bx);
        EpiPool E{MIX, pool_scale};
        pg8::gemm_phase<EpiPool, pg8::TileOrder, true, true>(lds, CC, 256, S, E);
    }
    SEAM(6);
    if (IN(7)) REP(7) {
        {   pg8::SplitOrder S{(const char*)MIX, (const char*)WOUT, (size_t)256 * D * 2, (size_t)256 * D * 2, D / 64, bx};
            EpiResid<false> E{H1, nullptr, nullptr, H2, 1.0f};
            pg8::gemm_phase<EpiResid<false>, pg8::SplitOrder, false, false>(lds, D, D, S, E); }
        {   pg8::TailOrder S{(const char*)MIX, (const char*)WOUT, (size_t)256 * D * 2, (size_t)256 * D * 2, D / 128, 16, 16, bx};
            EpiPartial E{PART_B, 16};
            pg8::gemm_phase<EpiPartial, pg8::TailOrder, false, false>(lds, D, D, S, E); }
    }
    SEAM(7);
    if (IN(8)) REP(8) {
        for (int m = gw; m < NPROMPT; m += NGW) norm_row_bf16(H2 + (size_t)m * D, ffn2_norm, XN + (size_t)m * D, lane);
        for (int h = wave * G + bx; h < NSAMP; h += 8 * G) {
            const int m = NPROMPT + h;
            heavy_row<false>(H1 + (size_t)m * D, 1.0f, PART_B, 16, h >> 8, h & 255, ffn2_norm, H2 + (size_t)m * D, XN + (size_t)m * D, lane);
        }
    }
    SEAM(8);
    if (IN(9)) REP(9) {
        pg8::TileOrder S; S.init(XN, W1B, (size_t)256 * D * 2, 0, (size_t)256 * D * 2, MR / 256, 2 * DFF / 256, D / 64, G, bx);
        EpiSwiglu E{ACT};
        pg8::gemm_phase<EpiSwiglu, pg8::TileOrder, true, true>(lds, D, D, S, E);
    }
    SEAM(9);
    if (IN(10)) REP(10) {
        {   pg8::SplitOrder S{(const char*)ACT, (const char*)W2B, (size_t)256 * DFF * 2, (size_t)256 * DFF * 2, DFF / 64, bx};
            EpiResid<false> E{H2, nullptr, nullptr, H2, 0.5f};
            pg8::gemm_phase<EpiResid<false>, pg8::SplitOrder, false, false>(lds, DFF, DFF, S, E); }
        {   pg8::TailOrder S{(const char*)ACT, (const char*)W2B, (size_t)256 * DFF * 2, (size_t)256 * DFF * 2, DFF / 128, 16, 16, bx};
            EpiPartial E{PART_C, 16};
            pg8::gemm_phase<EpiPartial, pg8::TailOrder, false, false>(lds, DFF, DFF, S, E); }
    }
    SEAM(10);
    if (IN(11)) REP(11) {
        for (int m = gw; m < NPROMPT; m += NGW) norm_row_f32_inplace(H2 + (size_t)m * D, final_norm, lane);
        for (int h = wave * G + bx; h < NSAMP; h += 8 * G) {
            const int m = NPROMPT + h;
            heavy_row<true>(H2 + (size_t)m * D, 0.5f, PART_C, 16, h >> 8, h & 255, final_norm, H2 + (size_t)m * D, nullptr, lane);
        }
    }
#undef IN
#undef SEAM
}

extern "C" void kernel_launch(void* const* d_in, const int* in_sizes, int n_in, void* d_out, int out_size, void* d_ws, size_t ws_size, hipStream_t stream) {
    static int grid = 0;
    if (grid == 0) {
        if (n_in != 22 || ws_size < WS_END) { fprintf(stderr, "kernel_launch: unexpected n_in %d / ws_size %zu (need %zu)\n", n_in, ws_size, (size_t)WS_END); grid = -1; return; }
        int dev = 0, cus = 0, per_cu = 0;
        (void)hipGetDevice(&dev); (void)hipDeviceGetAttribute(&cus, hipDeviceAttributeMultiprocessorCount, dev);
        if (hipFuncSetAttribute((const void*)mk_fwd, hipFuncAttributeMaxDynamicSharedMemorySize, LDS_BYTES) != hipSuccess) { fprintf(stderr, "kernel_launch: hipFuncSetAttribute failed\n"); grid = -1; return; }
        if (hipOccupancyMaxActiveBlocksPerMultiprocessor(&per_cu, (const void*)mk_fwd, 512, LDS_BYTES) != hipSuccess || per_cu < 1) { fprintf(stderr, "kernel_launch: occupancy query says %d\n", per_cu); per_cu = 1; }
        (void)hipGetLastError();
        grid = cus * 1;
        if (grid <= 0) grid = 256;
    }
    if (grid < 0) return;
    if (hipMemsetAsync((char*)d_ws + WS_CTL, 0, CTL_BYTES, stream) != hipSuccess) { fprintf(stderr, "kernel_launch: memset of the barrier words failed\n"); return; }
    Args a{};
    for (int i = 0; i < 22; ++i) a.in[i] = (const float*)d_in[i];
    a.out = (float*)d_out; a.ws = (unsigned char*)d_ws;
#if MK_MULTI
    for (int p = 0; p < N_PHASES; ++p) { a.ph_lo = p; a.ph_hi = p + 1; hipLaunchKernelGGL(mk_fwd, dim3(grid), dim3(512), LDS_BYTES, stream, a); }
#else
    a.ph_lo = 0; a.ph_hi = N_PHASES;
    void* kargs[] = {&a};
    hipError_t e = hipLaunchCooperativeKernel((const void*)mk_fwd, dim3(grid), dim3(512), kargs, LDS_BYTES, stream);
    if (e != hipSuccess) fprintf(stderr, "kernel_launch: cooperative launch failed: %s (grid %d)\n", hipGetErrorString(e), grid);
#endif
}
```
